# Optimizing an MI355X kernel written in HIP

```python
import math
import jax
import jax.numpy as jnp
from jax import lax
import numpy as np

D_MODEL = 1024
BATCH = 8
SEQ = 2048
DEPTH = 4

HEAD_DIM = 64
MIX_HALF = D_MODEL // 2
SGU_GROUPS = 4
SGU_WIDTH = MIX_HALF
SGU_GROUP_DIM = SGU_WIDTH // SGU_GROUPS
CHUNK = 128
DIFF_HEADS = MIX_HALF // (2 * HEAD_DIM)
DIFF_QK = DIFF_HEADS * 2 * HEAD_DIM
DIFF_V = DIFF_HEADS * 2 * HEAD_DIM
Q_BLOCK = 128
DIL_PAIRS = ((128, 1), (512, 4), (2048, 16))
DIL_GROUPS = len(DIL_PAIRS)
DIL_HEADS = MIX_HALF // HEAD_DIM
DIL_WIDTH = DIL_HEADS * HEAD_DIM
WIN_BLOCK = 128
CONV_WIDTH = MIX_HALF
CONV_K = 31
EVEN_IN = 2 * SGU_WIDTH + 2 * DIFF_QK + DIFF_V
ODD_IN = 2 * DIL_GROUPS * DIL_WIDTH + DIL_WIDTH + 2 * CONV_WIDTH
MIX_OUT = SGU_WIDTH + DIFF_V
N_EVEN = (DEPTH + 1) // 2
N_ODD = DEPTH // 2
N_EXPERTS = 16
N_EXPERT_GROUPS = 4
EXPERTS_PER_GROUP = N_EXPERTS // N_EXPERT_GROUPS
TOP_K = 2
EXPERT_FF = D_MODEL // 2
RMS_EPS = 1e-6
LN_EPS = 1e-5

kernel_name = 'hybrid_sgu_diffattn_dilated_conformer_moe'


def rms_norm(x, g):
    xf = x.astype(jnp.float32)
    y = xf * lax.rsqrt(jnp.mean(xf * xf, axis=-1, keepdims=True) + RMS_EPS)
    return (y * g.astype(jnp.float32)).astype(x.dtype)


def layer_norm(x, g, b):
    xf = x.astype(jnp.float32)
    mu = jnp.mean(xf, axis=-1, keepdims=True)
    var = jnp.mean(jnp.square(xf - mu), axis=-1, keepdims=True)
    y = (xf - mu) * lax.rsqrt(var + LN_EPS)
    return (y * g.astype(jnp.float32) + b.astype(jnp.float32)).astype(x.dtype)


def alibi_slopes(n_heads):
    return 2.0 ** (-8.0 * jnp.arange(1, n_heads + 1, dtype=jnp.float32) / n_heads)


def split_cols(x, sizes):
    outs, start = [], 0
    for s in sizes:
        outs.append(x[..., start:start + s])
        start += s
    return outs


def spatial_gating(u, v, ln_g, ln_b, w_s, b_s):
    bsz, seq, _ = v.shape
    v = layer_norm(v, ln_g, ln_b).reshape(bsz, seq // CHUNK, CHUNK, SGU_GROUPS, SGU_GROUP_DIM)
    causal = jnp.tril(jnp.ones((CHUNK, CHUNK), dtype=bool))
    w = jnp.where(causal, w_s, jnp.zeros_like(w_s))
    mixed = jnp.einsum('gts,bcsgd->bctgd', w, v) + b_s.T[None, None, :, :, None]
    return u * mixed.reshape(bsz, seq, SGU_WIDTH)


def differential_attention(q, k, v, lam, subln_g, lam_init):
    bsz, n_heads, _, seq, dh = q.shape
    n_blk = seq // Q_BLOCK
    scale = dh ** -0.5
    slopes = alibi_slopes(n_heads)
    k_pos = jnp.arange(seq)
    q_blocks = jnp.moveaxis(q.reshape(bsz, n_heads, 2, n_blk, Q_BLOCK, dh), 3, 0)

    def one_block(args):
        q_blk, blk = args
        q_pos = blk * Q_BLOCK + jnp.arange(Q_BLOCK)
        dist = q_pos[:, None] - k_pos[None, :]
        bias = -slopes[:, None, None] * dist.astype(jnp.float32)
        s = jnp.einsum('bhmqd,bhmkd->bhmqk', q_blk, k, preferred_element_type=jnp.float32)
        s = jnp.where(dist >= 0, s * scale + bias[None, :, None], -jnp.inf)
        p = jax.nn.softmax(s, axis=-1)
        a = p[:, :, 0] - lam * p[:, :, 1]
        return jnp.einsum('bhqk,bhkd->bhqd', a.astype(v.dtype), v)

    out = lax.map(one_block, (q_blocks, jnp.arange(n_blk)))
    out = jnp.moveaxis(out, 0, 2).reshape(bsz, n_heads, seq, 2 * dh)
    out = rms_norm(out, subln_g) * (1.0 - lam_init)
    return out.transpose(0, 2, 1, 3).reshape(bsz, seq, n_heads * 2 * dh)


def dilated_window_attention(q, k, v, slopes, window, dilation):
    bsz, n_heads, seq, dh = q.shape
    steps = window // dilation
    n_sub = seq // dilation
    n_blk = -(-n_sub // WIN_BLOCK)
    pad = n_blk * WIN_BLOCK - n_sub

    def to_sub(t):
        return t.reshape(bsz, n_heads, n_sub, dilation, dh).transpose(0, 1, 3, 2, 4)

    qs = jnp.pad(to_sub(q), ((0, 0), (0, 0), (0, 0), (0, pad), (0, 0)))
    kv_pad = ((0, 0), (0, 0), (0, 0), (WIN_BLOCK, pad), (0, 0))
    ks = jnp.pad(to_sub(k), kv_pad)
    vs = jnp.pad(to_sub(v), kv_pad)
    blk_shape = (bsz, n_heads, dilation, n_blk, WIN_BLOCK, dh)
    q_b = qs.reshape(blk_shape)

    def band(t):
        prev = t[:, :, :, :n_blk * WIN_BLOCK].reshape(blk_shape)
        cur = t[:, :, :, WIN_BLOCK:].reshape(blk_shape)
        return jnp.concatenate([prev, cur], axis=-2)

    k_b, v_b = band(ks), band(vs)
    i = jnp.arange(WIN_BLOCK)[:, None]
    j = jnp.arange(2 * WIN_BLOCK)[None, :]
    dist = i + WIN_BLOCK - j
    key_pos = (jnp.arange(n_blk)[:, None, None] - 1) * WIN_BLOCK + j[None]
    valid = (dist >= 0) & (dist <= steps) & (key_pos >= 0)
    bias = -slopes[:, None, None] * dist.astype(jnp.float32)
    s = jnp.einsum('bhrnqd,bhrnkd->bhrnqk', q_b, k_b, preferred_element_type=jnp.float32) * dh ** -0.5
    s = jnp.where(valid, s + bias[None, :, None, None], -jnp.inf)
    m = jnp.max(s, axis=-1, keepdims=True)
    p = jnp.exp(s - m)
    den = jnp.sum(p, axis=-1)
    o = jnp.einsum('bhrnqk,bhrnkd->bhrnqd', p.astype(v.dtype), v_b, preferred_element_type=jnp.float32)
    o = (o / den[..., None]).astype(v.dtype)
    lse = m[..., 0] + jnp.log(den)
    o = o.reshape(bsz, n_heads, dilation, n_blk * WIN_BLOCK, dh)[:, :, :, :n_sub]
    o = o.transpose(0, 1, 3, 2, 4).reshape(bsz, n_heads, seq, dh)
    lse = lse.reshape(bsz, n_heads, dilation, n_blk * WIN_BLOCK)[..., :n_sub]
    lse = lse.transpose(0, 1, 3, 2).reshape(bsz, n_heads, seq)
    return o, lse


def even_mixer(h, w_in, w_out, ln_g, ln_b, w_s, b_s, lq1, lk1, lq2, lk2, subln_g, lam_init):
    bsz, seq, _ = h.shape
    proj = h @ w_in
    u, v, q, k, vd = split_cols(proj, (SGU_WIDTH, SGU_WIDTH, DIFF_QK, DIFF_QK, DIFF_V))
    a_out = spatial_gating(jax.nn.gelu(u), jax.nn.gelu(v), ln_g, ln_b, w_s, b_s)
    q = q.reshape(bsz, seq, DIFF_HEADS, 2, HEAD_DIM).transpose(0, 2, 3, 1, 4)
    k = k.reshape(bsz, seq, DIFF_HEADS, 2, HEAD_DIM).transpose(0, 2, 3, 1, 4)
    vd = vd.reshape(bsz, seq, DIFF_HEADS, 2 * HEAD_DIM).transpose(0, 2, 1, 3)
    f32 = jnp.float32
    lam = (jnp.exp(jnp.sum(lq1.astype(f32) * lk1.astype(f32)))
           - jnp.exp(jnp.sum(lq2.astype(f32) * lk2.astype(f32))) + lam_init)
    b_out = differential_attention(q, k, vd, lam, subln_g, lam_init)
    return jnp.concatenate([a_out, b_out], axis=-1) @ w_out


def odd_mixer(h, w_in, w_out, conv_w, conv_b, conv_ln_g, conv_ln_b):
    bsz, seq, _ = h.shape
    proj = h @ w_in
    qc, kc, vc, dc = split_cols(proj, (DIL_GROUPS * DIL_WIDTH, DIL_GROUPS * DIL_WIDTH, DIL_WIDTH, 2 * CONV_WIDTH))

    def group_heads(t):
        return t.reshape(bsz, seq, DIL_GROUPS, DIL_HEADS, HEAD_DIM).transpose(2, 0, 3, 1, 4)

    qg, kg = group_heads(qc), group_heads(kc)
    v = vc.reshape(bsz, seq, DIL_HEADS, HEAD_DIM).transpose(0, 2, 1, 3)
    slopes = alibi_slopes(DIL_HEADS)
    outs, lses = [], []
    for g, (window, dilation) in enumerate(DIL_PAIRS):
        o, lse = dilated_window_attention(qg[g], kg[g], v, slopes, window, dilation)
        outs.append(o)
        lses.append(lse)
    wts = jax.nn.softmax(jnp.stack(lses), axis=0)
    c_out = jnp.sum(wts[..., None].astype(v.dtype) * jnp.stack(outs), axis=0)
    c_out = c_out.transpose(0, 2, 1, 3).reshape(bsz, seq, DIL_WIDTH)
    a, gate = split_cols(dc, (CONV_WIDTH, CONV_WIDTH))
    glu = a * jax.nn.sigmoid(gate)
    conv = lax.conv_general_dilated(glu, conv_w[:, None, :], window_strides=(1,),
                                    padding=((CONV_K - 1, 0),),
                                    dimension_numbers=('NWC', 'WIO', 'NWC'),
                                    feature_group_count=CONV_WIDTH) + conv_b
    d_out = jax.nn.silu(layer_norm(conv, conv_ln_g, conv_ln_b))
    return jnp.concatenate([c_out, d_out], axis=-1) @ w_out


def grouped_moe(h, router_w, router_b, w_gu, w_down):
    bsz, seq, dm = h.shape
    t = h.reshape(bsz * seq, dm)
    probs = jax.nn.softmax((t @ router_w).astype(jnp.float32), axis=-1)
    sel = (probs + router_b.astype(jnp.float32)).reshape(-1, N_EXPERT_GROUPS, EXPERTS_PER_GROUP)
    grp_score = jnp.sum(lax.top_k(sel, TOP_K)[0], axis=-1)
    grp = jnp.argmax(grp_score, axis=-1)
    in_grp = jnp.sum(sel * jax.nn.one_hot(grp, N_EXPERT_GROUPS, dtype=jnp.float32)[:, :, None], axis=1)
    _, local = lax.top_k(in_grp, TOP_K)
    experts = grp[:, None] * EXPERTS_PER_GROUP + local
    p_top = jnp.take_along_axis(probs, experts, axis=-1)
    gates = p_top / jnp.sum(p_top, axis=-1, keepdims=True)
    gate_dense = jnp.sum(jax.nn.one_hot(experts, N_EXPERTS, dtype=jnp.float32) * gates[..., None], axis=1)
    gu = jnp.einsum('td,edf->etf', t, w_gu)
    g, u = split_cols(gu, (EXPERT_FF, EXPERT_FF))
    act = jax.nn.silu(g) * u * gate_dense.T[:, :, None].astype(t.dtype)
    y = jnp.einsum('etf,efd->td', act, w_down)
    return y.reshape(bsz, seq, dm)


def setup_inputs(seed: int = 0) -> dict:
    key = jax.random.key(seed)
    ks = jax.random.split(key, 28)

    def nrm(k, shape, s):
        return jax.random.normal(k, shape, jnp.float32) * s

    return {
        'x': nrm(ks[0], (BATCH, SEQ, D_MODEL), 1.0),
        'c': nrm(ks[1], (BATCH, D_MODEL), 1.0),
        'norm1_g': 1.0 + nrm(ks[2], (DEPTH, D_MODEL), 0.02),
        'norm2_g': 1.0 + nrm(ks[3], (DEPTH, D_MODEL), 0.02),
        'ada_w': nrm(ks[4], (DEPTH, D_MODEL, 6 * D_MODEL), 0.5 * D_MODEL ** -0.5),
        'ada_b': nrm(ks[5], (DEPTH, 6 * D_MODEL), 0.02),
        'ev_w_in': nrm(ks[6], (N_EVEN, D_MODEL, EVEN_IN), D_MODEL ** -0.5),
        'ev_w_out': nrm(ks[7], (N_EVEN, MIX_OUT, D_MODEL), MIX_OUT ** -0.5),
        'sgu_ln_g': 1.0 + nrm(ks[8], (N_EVEN, SGU_WIDTH), 0.02),
        'sgu_ln_b': nrm(ks[9], (N_EVEN, SGU_WIDTH), 0.02),
        'sgu_w': nrm(ks[10], (N_EVEN, SGU_GROUPS, CHUNK, CHUNK), 0.5 * CHUNK ** -0.5),
        'sgu_b': 1.0 + nrm(ks[11], (N_EVEN, SGU_GROUPS, CHUNK), 0.02),
        'lam_q1': nrm(ks[12], (N_EVEN, HEAD_DIM), 0.1),
        'lam_k1': nrm(ks[13], (N_EVEN, HEAD_DIM), 0.1),
        'lam_q2': nrm(ks[14], (N_EVEN, HEAD_DIM), 0.1),
        'lam_k2': nrm(ks[15], (N_EVEN, HEAD_DIM), 0.1),
        'diff_subln_g': 1.0 + nrm(ks[16], (N_EVEN, 2 * HEAD_DIM), 0.02),
        'od_w_in': nrm(ks[17], (N_ODD, D_MODEL, ODD_IN), D_MODEL ** -0.5),
        'od_w_out': nrm(ks[18], (N_ODD, MIX_OUT, D_MODEL), MIX_OUT ** -0.5),
        'conv_w': nrm(ks[19], (N_ODD, CONV_K, CONV_WIDTH), CONV_K ** -0.5),
        'conv_b': nrm(ks[20], (N_ODD, CONV_WIDTH), 0.02),
        'conv_ln_g': 1.0 + nrm(ks[21], (N_ODD, CONV_WIDTH), 0.02),
        'conv_ln_b': nrm(ks[22], (N_ODD, CONV_WIDTH), 0.02),
        'router_w': nrm(ks[23], (D_MODEL, N_EXPERTS), D_MODEL ** -0.5),
        'router_b': nrm(ks[24], (N_EXPERTS,), 0.01),
        'moe_w_gu': nrm(ks[25], (DEPTH, N_EXPERTS, D_MODEL, 2 * EXPERT_FF), D_MODEL ** -0.5),
        'moe_w_down': nrm(ks[26], (DEPTH, N_EXPERTS, EXPERT_FF, D_MODEL), EXPERT_FF ** -0.5),
        'final_g': 1.0 + nrm(ks[27], (D_MODEL,), 0.02),
    }


def reference(x, c, norm1_g, norm2_g, ada_w, ada_b, ev_w_in, ev_w_out, sgu_ln_g, sgu_ln_b,
              sgu_w, sgu_b, lam_q1, lam_k1, lam_q2, lam_k2, diff_subln_g, od_w_in, od_w_out,
              conv_w, conv_b, conv_ln_g, conv_ln_b, router_w, router_b, moe_w_gu, moe_w_down,
              final_g):
    bsz = x.shape[0]
    c_act = jax.nn.silu(c)
    for l in range(DEPTH):
        mod = (c_act @ ada_w[l] + ada_b[l]).reshape(bsz, 6, 1, D_MODEL)
        sh1, sc1, g1, sh2, sc2, g2 = (mod[:, i] for i in range(6))
        h = rms_norm(x, norm1_g[l]) * (1.0 + sc1) + sh1
        i = l // 2
        if l % 2 == 0:
            lam_init = 0.8 - 0.6 * math.exp(-0.3 * l)
            y = even_mixer(h, ev_w_in[i], ev_w_out[i], sgu_ln_g[i], sgu_ln_b[i], sgu_w[i], sgu_b[i],
                           lam_q1[i], lam_k1[i], lam_q2[i], lam_k2[i], diff_subln_g[i], lam_init)
        else:
            y = odd_mixer(h, od_w_in[i], od_w_out[i], conv_w[i], conv_b[i], conv_ln_g[i], conv_ln_b[i])
        x = x + g1 * y
        h = rms_norm(x, norm2_g[l]) * (1.0 + sc2) + sh2
        x = x + g2 * grouped_moe(h, router_w, router_b, moe_w_gu[l], moe_w_down[l])
    return rms_norm(x, final_g)
```

```cpp
#include <hip/hip_runtime.h>
#include <stdint.h>
#include <stdio.h>

typedef unsigned short bf16_t;
typedef float f32x4 __attribute__((ext_vector_type(4)));

constexpr int NB = 8, SEQ = 2048, DM = 1024, T = NB * SEQ, DEPTH = 4;
constexpr int EVEN_IN = 2560, ODD_IN = 4608;
constexpr int NEXP = 16, EFF = 512, CAP = 16384;

__device__ __forceinline__ float bf2f(bf16_t v) { return __uint_as_float(((unsigned)v) << 16); }
__device__ __forceinline__ bf16_t f2bf(float f) { unsigned u = __float_as_uint(f); return (bf16_t)((u + 0x7fffu + ((u >> 16) & 1u)) >> 16); }
__device__ __forceinline__ float gelu_tanh(float x) { return 0.5f * x * (1.f + tanhf(0.7978845608028654f * (x + 0.044715f * x * x * x))); }
__device__ __forceinline__ float sigmoidf_(float x) { return 1.f / (1.f + __expf(-x)); }
__device__ __forceinline__ float wave_sum(float v) {
#pragma unroll
    for (int o = 1; o < 64; o <<= 1) v += __shfl_xor(v, o);
    return v;
}
__device__ __forceinline__ float wave_max(float v) {
#pragma unroll
    for (int o = 1; o < 64; o <<= 1) v = fmaxf(v, __shfl_xor(v, o));
    return v;
}
__device__ __forceinline__ float block_sum256(float v, float* red) {
    v = wave_sum(v);
    __syncthreads();
    if ((threadIdx.x & 63) == 0) red[threadIdx.x >> 6] = v;
    __syncthreads();
    return red[0] + red[1] + red[2] + red[3];
}

constexpr size_t MiB = 1u << 20;
constexpr size_t WS_CTL = 0;
constexpr size_t WS_MOD = 1 * MiB;
constexpr size_t WS_X = 2 * MiB;
constexpr size_t WS_XN = WS_X + 64 * MiB;
constexpr size_t WS_PROJ = WS_XN + 32 * MiB;
constexpr size_t WS_MIX = WS_PROJ + 144 * MiB;
constexpr size_t WS_VN = WS_MIX + 32 * MiB;
constexpr size_t WS_ACT = WS_VN + 16 * MiB;
constexpr size_t WS_YS = WS_ACT + 32 * MiB;
constexpr size_t WS_LIST = WS_YS + 64 * MiB;
constexpr size_t WS_GATE = WS_LIST + 1 * MiB;
constexpr size_t WS_END = WS_GATE + 1 * MiB;

__global__ __launch_bounds__(256) void k_mod(const float* __restrict__ c, const float* __restrict__ ada_w, const float* __restrict__ ada_b, float* __restrict__ mod) {
    __shared__ float ca[NB][DM];
    for (int i = threadIdx.x; i < NB * DM; i += 256) { float v = c[i]; ca[i / DM][i % DM] = v * sigmoidf_(v); }
    __syncthreads();
    const int gid = blockIdx.x * 256 + threadIdx.x;
    const int l = gid / 6144, j = gid % 6144;
    const float* w = ada_w + (size_t)l * DM * 6144 + j;
    float acc[NB];
#pragma unroll
    for (int b = 0; b < NB; ++b) acc[b] = 0.f;
    for (int k = 0; k < DM; ++k) {
        const float wv = w[(size_t)k * 6144];
#pragma unroll
        for (int b = 0; b < NB; ++b) acc[b] += ca[b][k] * wv;
    }
    const float bias = ada_b[l * 6144 + j];
#pragma unroll
    for (int b = 0; b < NB; ++b) mod[((size_t)l * NB + b) * 6144 + j] = acc[b] + bias;
}

template <bool FIRST, bool ADDMOE>
__global__ __launch_bounds__(256) void k_norm_mod(const float* __restrict__ xin, float* __restrict__ X, const bf16_t* __restrict__ YS, const float* __restrict__ g2prev,
                                                  const float* __restrict__ ng, const float* __restrict__ sc, const float* __restrict__ sh, bf16_t* __restrict__ XN) {
    const int lane = threadIdx.x & 63, row = blockIdx.x * 4 + (threadIdx.x >> 6), b = row / SEQ;
    f32x4 v[4]; float ss = 0.f;
#pragma unroll
    for (int j = 0; j < 4; ++j) {
        const int col = j * 256 + lane * 4;
        v[j] = *(const f32x4*)((FIRST ? xin : X) + (size_t)row * DM + col);
        if (ADDMOE) {
            const f32x4 g = *(const f32x4*)(g2prev + b * 6144 + col);
            const bf16_t* y0 = YS + (size_t)(2 * row) * DM + col; const bf16_t* y1 = y0 + DM;
#pragma unroll
            for (int i = 0; i < 4; ++i) v[j][i] += g[i] * (bf2f(y0[i]) + bf2f(y1[i]));
        }
        if (FIRST || ADDMOE) *(f32x4*)(X + (size_t)row * DM + col) = v[j];
        ss += v[j][0] * v[j][0] + v[j][1] * v[j][1] + v[j][2] * v[j][2] + v[j][3] * v[j][3];
    }
    const float r = rsqrtf(wave_sum(ss) * (1.f / DM) + 1e-6f);
#pragma unroll
    for (int j = 0; j < 4; ++j) {
        const int col = j * 256 + lane * 4;
        const f32x4 g = *(const f32x4*)(ng + col), s1 = *(const f32x4*)(sc + b * 6144 + col), s0 = *(const f32x4*)(sh + b * 6144 + col);
        bf16_t* o = XN + (size_t)row * DM + col;
#pragma unroll
        for (int i = 0; i < 4; ++i) o[i] = f2bf(v[j][i] * r * g[i] * (1.f + s1[i]) + s0[i]);
    }
}

__global__ __launch_bounds__(256) void k_final(const float* __restrict__ X, const bf16_t* __restrict__ YS, const float* __restrict__ g2prev, const float* __restrict__ fg, float* __restrict__ out) {
    const int lane = threadIdx.x & 63, row = blockIdx.x * 4 + (threadIdx.x >> 6), b = row / SEQ;
    f32x4 v[4]; float ss = 0.f;
#pragma unroll
    for (int j = 0; j < 4; ++j) {
        const int col = j * 256 + lane * 4;
        v[j] = *(const f32x4*)(X + (size_t)row * DM + col);
        const f32x4 g = *(const f32x4*)(g2prev + b * 6144 + col);
        const bf16_t* y0 = YS + (size_t)(2 * row) * DM + col; const bf16_t* y1 = y0 + DM;
#pragma unroll
        for (int i = 0; i < 4; ++i) v[j][i] += g[i] * (bf2f(y0[i]) + bf2f(y1[i]));
        ss += v[j][0] * v[j][0] + v[j][1] * v[j][1] + v[j][2] * v[j][2] + v[j][3] * v[j][3];
    }
    const float r = rsqrtf(wave_sum(ss) * (1.f / DM) + 1e-6f);
#pragma unroll
    for (int j = 0; j < 4; ++j) {
        const int col = j * 256 + lane * 4;
        const f32x4 g = *(const f32x4*)(fg + col);
        f32x4 o;
#pragma unroll
        for (int i = 0; i < 4; ++i) o[i] = v[j][i] * r * g[i];
        *(f32x4*)(out + (size_t)row * DM + col) = o;
    }
}

template <int MODE>
__global__ __launch_bounds__(256) void k_gemm(const bf16_t* __restrict__ A, int lda, const float* __restrict__ Bw, int ldb, int K,
                                              bf16_t* __restrict__ Cb, float* __restrict__ Xf, int ldc, const float* __restrict__ gvec,
                                              const int* __restrict__ list, const int* __restrict__ cnt, const float* __restrict__ gates, size_t bstride) {
    __shared__ float As[16][68];
    __shared__ float Bs[16][64];
    __shared__ float Bs2[16][64];
    __shared__ int rsrc[64];
    const int tid = threadIdx.x, e = blockIdx.z, n0 = blockIdx.x * 64, m0 = blockIdx.y * 64;
    const int count = (MODE >= 2) ? cnt[e] : T;
    if (m0 >= count) return;
    const float* Bp = Bw + ((MODE >= 2) ? (size_t)e * bstride : 0);
    if (tid < 64) { const int r = m0 + tid; int ent = r; if (MODE >= 2) ent = (r < count) ? list[e * CAP + r] : -1; rsrc[tid] = ent; }
    __syncthreads();
    const int ar = tid >> 2, ak = (tid & 3) * 4;
    int aent = rsrc[ar]; int asrc = aent < 0 ? 0 : (MODE == 2 ? (aent >> 1) : aent);
    const bf16_t* ap = A + (size_t)asrc * lda + ak;
    const int bk = tid >> 4, bn = (tid & 15) * 4;
    const int tx = tid & 15, ty = tid >> 4;
    float acc[4][4], acc2[4][4];
#pragma unroll
    for (int i = 0; i < 4; ++i)
#pragma unroll
        for (int j = 0; j < 4; ++j) { acc[i][j] = 0.f; acc2[i][j] = 0.f; }
    for (int k0 = 0; k0 < K; k0 += 16) {
        const uint2 av = *(const uint2*)(ap + k0);
        const f32x4 bv = *(const f32x4*)(Bp + (size_t)(k0 + bk) * ldb + n0 + bn);
        f32x4 bv2 = bv;
        if (MODE == 2) bv2 = *(const f32x4*)(Bp + (size_t)(k0 + bk) * ldb + n0 + bn + EFF);
        __syncthreads();
        As[ak + 0][ar] = __uint_as_float(av.x << 16); As[ak + 1][ar] = __uint_as_float(av.x & 0xffff0000u);
        As[ak + 2][ar] = __uint_as_float(av.y << 16); As[ak + 3][ar] = __uint_as_float(av.y & 0xffff0000u);
        *(f32x4*)&Bs[bk][bn] = bv;
        if (MODE == 2) *(f32x4*)&Bs2[bk][bn] = bv2;
        __syncthreads();
#pragma unroll
        for (int k = 0; k < 16; ++k) {
            const f32x4 a = *(const f32x4*)&As[k][ty * 4];
            const f32x4 b = *(const f32x4*)&Bs[k][tx * 4];
#pragma unroll
            for (int i = 0; i < 4; ++i)
#pragma unroll
                for (int j = 0; j < 4; ++j) acc[i][j] += a[i] * b[j];
            if (MODE == 2) {
                const f32x4 b2 = *(const f32x4*)&Bs2[k][tx * 4];
#pragma unroll
                for (int i = 0; i < 4; ++i)
#pragma unroll
                    for (int j = 0; j < 4; ++j) acc2[i][j] += a[i] * b2[j];
            }
        }
    }
#pragma unroll
    for (int i = 0; i < 4; ++i) {
        const int ent = rsrc[ty * 4 + i];
        if (ent < 0) continue;
        const int col = n0 + tx * 4;
        if (MODE == 0) {
            bf16_t* o = Cb + (size_t)ent * ldc + col;
#pragma unroll
            for (int j = 0; j < 4; ++j) o[j] = f2bf(acc[i][j]);
        } else if (MODE == 1) {
            const int b = ent / SEQ;
            float* o = Xf + (size_t)ent * ldc + col;
#pragma unroll
            for (int j = 0; j < 4; ++j) o[j] += gvec[b * 6144 + col + j] * acc[i][j];
        } else if (MODE == 2) {
            const float gt = gates[ent];
            bf16_t* o = Cb + (size_t)ent * ldc + col;
#pragma unroll
            for (int j = 0; j < 4; ++j) { const float g = acc[i][j]; o[j] = f2bf(g * sigmoidf_(g) * acc2[i][j] * gt); }
        } else {
            bf16_t* o = Cb + (size_t)ent * ldc + col;
#pragma unroll
            for (int j = 0; j < 4; ++j) o[j] = f2bf(acc[i][j]);
        }
    }
}

__global__ __launch_bounds__(256) void k_sgu_pre(const bf16_t* __restrict__ PROJ, const float* __restrict__ lg, const float* __restrict__ lb, bf16_t* __restrict__ VN, int fused) {
    __shared__ float red[4];
    const int tok = blockIdx.x, tid = threadIdx.x;
    float a = bf2f(PROJ[(size_t)tok * EVEN_IN + 512 + tid]), b = bf2f(PROJ[(size_t)tok * EVEN_IN + 768 + tid]);
    if (!fused) { a = gelu_tanh(a); b = gelu_tanh(b); }
    const float mean = block_sum256(a + b, red) * (1.f / 512.f);
    const float da = a - mean, db = b - mean;
    const float var = block_sum256(da * da + db * db, red) * (1.f / 512.f);
    const float r = rsqrtf(var + 1e-5f);
    VN[(size_t)tok * 512 + tid] = f2bf(da * r * lg[tid] + lb[tid]);
    VN[(size_t)tok * 512 + 256 + tid] = f2bf(db * r * lg[256 + tid] + lb[256 + tid]);
}
__global__ __launch_bounds__(256) void k_sgu_mix(const bf16_t* __restrict__ PROJ, const bf16_t* __restrict__ VN, const float* __restrict__ W, const float* __restrict__ bs, bf16_t* __restrict__ MIX, int fused) {
    __shared__ bf16_t vn[128][128];
    const int bc = blockIdx.x, g = blockIdx.y, tid = threadIdx.x;
    const int tok0 = bc * 128;
    for (int i = tid; i < 128 * 128; i += 256) { const int s = i >> 7, d = i & 127; vn[s][d] = VN[(size_t)(tok0 + s) * 512 + g * 128 + d]; }
    __syncthreads();
    const int d = tid & 127, half = tid >> 7;
    for (int t = half; t < 128; t += 2) {
        const float* w = W + ((size_t)g * 128 + t) * 128;
        float acc = 0.f;
        for (int s = 0; s <= t; ++s) acc += w[s] * bf2f(vn[s][d]);
        float u = bf2f(PROJ[(size_t)(tok0 + t) * EVEN_IN + g * 128 + d]); if (!fused) u = gelu_tanh(u);
        MIX[(size_t)(tok0 + t) * DM + g * 128 + d] = f2bf(u * (acc + bs[g * 128 + t]));
    }
}

__global__ __launch_bounds__(128) void k_diff_naive(const bf16_t* __restrict__ PROJ, const float* __restrict__ lq1, const float* __restrict__ lk1, const float* __restrict__ lq2, const float* __restrict__ lk2,
                                                    const float* __restrict__ subg, float lam_init, bf16_t* __restrict__ MIX, int fused) {
    __shared__ float sc[2][2][SEQ];
    const float qsc = fused ? 0.6931471805599453f : 0.125f;
    __shared__ float qs[2][128];
    const int lane = threadIdx.x & 63, w = threadIdx.x >> 6;
    const int idx = blockIdx.x * 2 + w, h = idx & 3, tok = idx >> 2, b = tok / SEQ, qpos = tok % SEQ;
    const float lam = __expf(wave_sum(lq1[lane] * lk1[lane])) - __expf(wave_sum(lq2[lane] * lk2[lane])) + lam_init;
    const float slope = exp2f(-2.f * (float)(h + 1));
    qs[w][lane] = bf2f(PROJ[(size_t)tok * EVEN_IN + 1024 + h * 128 + lane]);
    qs[w][64 + lane] = bf2f(PROJ[(size_t)tok * EVEN_IN + 1024 + h * 128 + 64 + lane]);
    __syncthreads();
    float m0 = -INFINITY, m1 = -INFINITY;
    const int nch = qpos / 64 + 1;
    for (int c = 0; c < nch; ++c) {
        const int key = c * 64 + lane;
        float s0 = -INFINITY, s1 = -INFINITY;
        if (key <= qpos) {
            const bf16_t* kp = PROJ + (size_t)(b * SEQ + key) * EVEN_IN + 1536 + h * 128;
            float a0 = 0.f, a1 = 0.f;
            for (int d = 0; d < 64; ++d) { a0 += qs[w][d] * bf2f(kp[d]); a1 += qs[w][64 + d] * bf2f(kp[64 + d]); }
            const float bias = -slope * (float)(qpos - key);
            s0 = a0 * qsc + bias; s1 = a1 * qsc + bias;
        }
        sc[w][0][key] = s0; sc[w][1][key] = s1;
        m0 = fmaxf(m0, s0); m1 = fmaxf(m1, s1);
    }
    m0 = wave_max(m0); m1 = wave_max(m1);
    float l0 = 0.f, l1 = 0.f;
    for (int c = 0; c < nch; ++c) { const int key = c * 64 + lane; l0 += __expf(sc[w][0][key] - m0); l1 += __expf(sc[w][1][key] - m1); }
    l0 = wave_sum(l0); l1 = wave_sum(l1);
    const float i0 = 1.f / l0, i1 = lam / l1;
    for (int c = 0; c < nch; ++c) { const int key = c * 64 + lane; const float a = __expf(sc[w][0][key] - m0) * i0 - __expf(sc[w][1][key] - m1) * i1; sc[w][0][key] = a; }
    __syncthreads();
    float o0 = 0.f, o1 = 0.f;
    for (int key = 0; key <= qpos; ++key) {
        const float a = sc[w][0][key];
        const unsigned vv = *(const unsigned*)(PROJ + (size_t)(b * SEQ + key) * EVEN_IN + 2048 + h * 128 + 2 * lane);
        o0 += a * __uint_as_float(vv << 16); o1 += a * __uint_as_float(vv & 0xffff0000u);
    }
    const float r = rsqrtf(wave_sum(o0 * o0 + o1 * o1) * (1.f / 128.f) + 1e-6f) * (1.f - lam_init);
    bf16_t* o = MIX + (size_t)tok * DM + 512 + h * 128 + 2 * lane;
    o[0] = f2bf(o0 * r * subg[2 * lane]); o[1] = f2bf(o1 * r * subg[2 * lane + 1]);
}

__global__ __launch_bounds__(256) void k_dil_naive(const bf16_t* __restrict__ PROJ, bf16_t* __restrict__ MIX, int fused) {
    __shared__ float qs[4][3][64];
    const float qsc = fused ? 0.6931471805599453f : 0.125f;
    const int lane = threadIdx.x & 63, w = threadIdx.x >> 6;
    const int idx = blockIdx.x * 4 + w, h = idx & 7, tok = idx >> 3, b = tok / SEQ, t = tok % SEQ;
    const float slope = exp2f(-(float)(h + 1));
#pragma unroll
    for (int g = 0; g < 3; ++g) qs[w][g][lane] = bf2f(PROJ[(size_t)tok * ODD_IN + g * 512 + h * 64 + lane]);
    __syncthreads();
    float p[3][3];
    float mx = -INFINITY;
#pragma unroll
    for (int g = 0; g < 3; ++g) {
        const int dil = (g == 0) ? 1 : (g == 1 ? 4 : 16);
#pragma unroll
        for (int jj = 0; jj < 3; ++jj) {
            const int j = jj * 64 + lane, pos = t - j * dil;
            float s = -INFINITY;
            if (j <= 128 && pos >= 0) {
                const bf16_t* kp = PROJ + (size_t)(b * SEQ + pos) * ODD_IN + 1536 + g * 512 + h * 64;
                float a = 0.f;
                for (int d = 0; d < 64; ++d) a += qs[w][g][d] * bf2f(kp[d]);
                s = a * qsc - slope * (float)j;
            }
            p[g][jj] = s; mx = fmaxf(mx, s);
        }
    }
    mx = wave_max(mx);
    float l = 0.f;
#pragma unroll
    for (int g = 0; g < 3; ++g)
#pragma unroll
        for (int jj = 0; jj < 3; ++jj) { p[g][jj] = __expf(p[g][jj] - mx); l += p[g][jj]; }
    l = wave_sum(l);
    float o = 0.f;
#pragma unroll
    for (int g = 0; g < 3; ++g) {
        const int dil = (g == 0) ? 1 : (g == 1 ? 4 : 16);
#pragma unroll
        for (int jj = 0; jj < 3; ++jj) {
            const int nk = (jj == 2) ? 1 : 64;
            for (int kk = 0; kk < nk; ++kk) {
                const float pk = __shfl(p[g][jj], kk);
                int pos = t - (jj * 64 + kk) * dil; if (pos < 0) pos = 0;
                o += pk * bf2f(PROJ[(size_t)(b * SEQ + pos) * ODD_IN + 3072 + h * 64 + lane]);
            }
        }
    }
    MIX[(size_t)tok * DM + h * 64 + lane] = f2bf(o / l);
}

__global__ __launch_bounds__(256) void k_conv_naive(const bf16_t* __restrict__ PROJ, const float* __restrict__ cw, const float* __restrict__ cb, const float* __restrict__ lg, const float* __restrict__ lb, bf16_t* __restrict__ MIX) {
    __shared__ float red[4];
    const int tok = blockIdx.x, tid = threadIdx.x, t = tok % SEQ;
    float v[2];
#pragma unroll
    for (int i = 0; i < 2; ++i) {
        const int ch = tid + i * 256;
        float acc = cb[ch];
        for (int k = 0; k < 31; ++k) {
            const int tt = t - 30 + k;
            if (tt >= 0) {
                const bf16_t* p = PROJ + (size_t)(tok - 30 + k) * ODD_IN + 3584 + ch;
                acc += cw[k * 512 + ch] * bf2f(p[0]) * sigmoidf_(bf2f(p[512]));
            }
        }
        v[i] = acc;
    }
    const float mean = block_sum256(v[0] + v[1], red) * (1.f / 512.f);
    const float d0 = v[0] - mean, d1 = v[1] - mean;
    const float var = block_sum256(d0 * d0 + d1 * d1, red) * (1.f / 512.f);
    const float r = rsqrtf(var + 1e-5f);
    const float y0 = d0 * r * lg[tid] + lb[tid], y1 = d1 * r * lg[tid + 256] + lb[tid + 256];
    MIX[(size_t)tok * DM + 512 + tid] = f2bf(y0 * sigmoidf_(y0));
    MIX[(size_t)tok * DM + 768 + tid] = f2bf(y1 * sigmoidf_(y1));
}

__global__ __launch_bounds__(256) void k_norm_router(const float* __restrict__ X, const float* __restrict__ ng, const float* __restrict__ sc, const float* __restrict__ sh,
                                                     const float* __restrict__ rw, const float* __restrict__ rb, bf16_t* __restrict__ XN, int* __restrict__ cnt, int* __restrict__ list, float* __restrict__ gates) {
    const int lane = threadIdx.x & 63, row = blockIdx.x * 4 + (threadIdx.x >> 6), b = row / SEQ;
    f32x4 v[4]; float ss = 0.f;
#pragma unroll
    for (int j = 0; j < 4; ++j) {
        const int col = j * 256 + lane * 4;
        v[j] = *(const f32x4*)(X + (size_t)row * DM + col);
        ss += v[j][0] * v[j][0] + v[j][1] * v[j][1] + v[j][2] * v[j][2] + v[j][3] * v[j][3];
    }
    const float r = rsqrtf(wave_sum(ss) * (1.f / DM) + 1e-6f);
    float lg[16];
#pragma unroll
    for (int e = 0; e < 16; ++e) lg[e] = 0.f;
#pragma unroll
    for (int j = 0; j < 4; ++j) {
        const int col = j * 256 + lane * 4;
        const f32x4 g = *(const f32x4*)(ng + col), s1 = *(const f32x4*)(sc + b * 6144 + col), s0 = *(const f32x4*)(sh + b * 6144 + col);
        bf16_t* o = XN + (size_t)row * DM + col;
#pragma unroll
        for (int i = 0; i < 4; ++i) {
            const float hv = v[j][i] * r * g[i] * (1.f + s1[i]) + s0[i];
            o[i] = f2bf(hv);
            const float* wr = rw + (size_t)(col + i) * 16;
#pragma unroll
            for (int q = 0; q < 4; ++q) { const f32x4 wv = *(const f32x4*)(wr + 4 * q); lg[4 * q + 0] += hv * wv[0]; lg[4 * q + 1] += hv * wv[1]; lg[4 * q + 2] += hv * wv[2]; lg[4 * q + 3] += hv * wv[3]; }
        }
    }
    float mx = -INFINITY;
#pragma unroll
    for (int e = 0; e < 16; ++e) { lg[e] = wave_sum(lg[e]); mx = fmaxf(mx, lg[e]); }
    float sum = 0.f;
#pragma unroll
    for (int e = 0; e < 16; ++e) { lg[e] = __expf(lg[e] - mx); sum += lg[e]; }
    const float inv = 1.f / sum;
    float sel[16];
#pragma unroll
    for (int e = 0; e < 16; ++e) { lg[e] *= inv; sel[e] = lg[e] + rb[e]; }
    int grp = 0; float best = -INFINITY;
#pragma unroll
    for (int g = 0; g < 4; ++g) {
        float m1 = -INFINITY, m2 = -INFINITY;
#pragma unroll
        for (int i = 0; i < 4; ++i) { const float s = sel[4 * g + i]; if (s > m1) { m2 = m1; m1 = s; } else if (s > m2) m2 = s; }
        const float gs = m1 + m2;
        if (gs > best) { best = gs; grp = g; }
    }
    float s4[4], p4[4];
#pragma unroll
    for (int i = 0; i < 4; ++i) { s4[i] = 0.f; p4[i] = 0.f; }
#pragma unroll
    for (int g = 0; g < 4; ++g)
#pragma unroll
        for (int i = 0; i < 4; ++i) if (g == grp) { s4[i] = sel[4 * g + i]; p4[i] = lg[4 * g + i]; }
    int i1 = 0; float b1 = s4[0];
#pragma unroll
    for (int i = 1; i < 4; ++i) if (s4[i] > b1) { b1 = s4[i]; i1 = i; }
    int i2 = -1; float b2 = -INFINITY;
#pragma unroll
    for (int i = 0; i < 4; ++i) if (i != i1 && s4[i] > b2) { b2 = s4[i]; i2 = i; }
    float pa = 0.f, pb = 0.f;
#pragma unroll
    for (int i = 0; i < 4; ++i) { if (i == i1) pa = p4[i]; if (i == i2) pb = p4[i]; }
    if (lane == 0) {
        const int e1 = grp * 4 + i1, e2 = grp * 4 + i2;
        const float gi = 1.f / (pa + pb);
        const int p1 = atomicAdd(cnt + e1, 1), p2 = atomicAdd(cnt + e2, 1);
        list[e1 * CAP + p1] = row * 2; list[e2 * CAP + p2] = row * 2 + 1;
        gates[row * 2] = pa * gi; gates[row * 2 + 1] = pb * gi;
    }
}

constexpr int CNT_STRIDE = 64;
__device__ __forceinline__ int hw_lane() { unsigned z = 0u; asm volatile("" : "+v"(z)); return (int)__builtin_amdgcn_mbcnt_hi(~0u, __builtin_amdgcn_mbcnt_lo(~0u, z)); }
namespace pg8 {
#define PG8_LAS __attribute__((address_space(3)))
typedef short bf16x8 __attribute__((ext_vector_type(8)));
typedef unsigned u32x4 __attribute__((ext_vector_type(4)));
typedef float f32x2 __attribute__((ext_vector_type(2)));
constexpr int BM = 256, BK = 64, HALF = 128, HTB = HALF * BK * 2, STAGE_BYTES = 8 * HTB, NXCD = 8, WGM = 8;

__host__ __device__ __forceinline__ int lds_byte(int r, int c) { const int st = (r >> 4) * 2 + (c >> 5), rr = r & 15, cc = c & 31, ob = rr * 64 + cc * 2; return st * 1024 + (ob ^ (((ob >> 9) & 1) << 5)); }
__host__ __device__ __forceinline__ void stage_rc(int b, int& R, int& C) { const int st = b / 1024, sb = b % 1024, swz = sb ^ (((sb >> 9) & 1) << 5); R = (st >> 1) * 16 + swz / 64; C = (st & 1) * 32 + (swz % 64) / 2; }
__host__ __device__ __forceinline__ int perm32(int rho) { const int n = rho >> 4, i = rho & 15; return 8 * (i >> 2) + 4 * n + (i & 3); }

struct Unit { int pm, pn, e, cnt; };
struct Gemm { const bf16_t* A; const bf16_t* Bt; int K; size_t bstride; };

__device__ __forceinline__ unsigned cvt_pk_bf16(float lo, float hi) { unsigned r; asm volatile("v_cvt_pk_bf16_f32 %0, %1, %2" : "=v"(r) : "v"(lo), "v"(hi)); return r; }

struct StaticOrder {
    int nM, nN, nwg, G, c;
    __device__ void init(int M, int N, int G_, int c_) { nM = M / BM; nN = N / BM; nwg = nM * nN; G = G_; c = c_; }
    __device__ __forceinline__ bool next(int i, Unit& u) const {
        const long L = (long)i * G + c; if (L >= nwg) return false;
        int wgid = (int)L; { const int q = nwg / NXCD, r = nwg % NXCD, xcd = wgid % NXCD, off = wgid / NXCD; wgid = (xcd < r ? xcd * (q + 1) : r * (q + 1) + (xcd - r) * q) + off; }
        const int nig = WGM * nN, gid = wgid / nig, fm = gid * WGM, gsz = (nM - fm) < WGM ? (nM - fm) : WGM;
        u.pm = fm + ((wgid % nig) % gsz); u.pn = (wgid % nig) / gsz; u.e = 0; u.cnt = 0; return true;
    }
    __device__ __forceinline__ unsigned arow(const Unit& u, int r) const { return (unsigned)(u.pm * BM + r); }
    static constexpr bool HAS_TAB = false;
    __device__ __forceinline__ unsigned long long record(const Unit&, int) const { return 0ull; }
    __device__ __forceinline__ bool filler_rank(int& rank, int& npart) const { const int rem = nwg % G; if (rem == 0) { rank = c; npart = G; return true; } rank = c - rem; npart = G - rem; return c >= rem; }
};
template <int SHIFT>
struct MoeOrder {
    PG8_LAS const int* cnt; const int* list; int nN, G, c;
    __device__ __forceinline__ int total_units() const { int acc = 0;
#pragma unroll
        for (int j = 0; j < NEXP; ++j) acc += (__builtin_amdgcn_readfirstlane(cnt[j]) + BM - 1) / BM;
        return acc * nN; }
    __device__ __forceinline__ void chunk(int U, int x, int& start, int& n) const { const int q = U / NXCD, rm = U % NXCD; n = q + (x < rm ? 1 : 0); start = x * q + (x < rm ? x : rm); }
    __device__ __forceinline__ int my_units(int U) const { int st, n; chunk(U, c % NXCD, st, n); const int r = c / NXCD, W = G / NXCD; return r < n ? (n - r + W - 1) / W : 0; }
    __device__ __forceinline__ int max_units(int U) const { const int W = G / NXCD, nmax = (U + NXCD - 1) / NXCD; return (nmax + W - 1) / W; }
    __device__ __forceinline__ bool next(int i, Unit& u) const {
        int acc = 0; int cj[NEXP];
#pragma unroll
        for (int j = 0; j < NEXP; ++j) { cj[j] = __builtin_amdgcn_readfirstlane(cnt[j]); acc += (cj[j] + BM - 1) / BM; }
        const int U = acc * nN, W = G / NXCD;
        int st, n; chunk(U, c % NXCD, st, n);
        const int jloc = i * W + c / NXCD;
        if (jloc >= n) return false;
        const int uid = st + jloc, mtg = uid / nN; u.pn = uid % nN;
        int e = 0, base = 0, ce = 0; acc = 0;
#pragma unroll
        for (int j = 0; j < NEXP; ++j) { if (j == e) ce = cj[j]; acc += (cj[j] + BM - 1) / BM; if (mtg >= acc) { e = j + 1; base = acc; } }
        u.e = e; u.pm = mtg - base; u.cnt = ce; return true;
    }
    __device__ __forceinline__ unsigned arow(const Unit& u, int r) const {
        int rr = u.pm * BM + r; rr = rr < u.cnt ? rr : u.cnt - 1;
        const int ent = __hip_atomic_load(list + 2 * (u.e * CAP + rr), __ATOMIC_RELAXED, __HIP_MEMORY_SCOPE_AGENT);
        return (unsigned)(ent >> SHIFT);
    }
    static constexpr bool HAS_TAB = true;
    __device__ __forceinline__ unsigned long long record(const Unit& u, int r) const {
        int rr = u.pm * BM + r; rr = rr < u.cnt ? rr : u.cnt - 1;
        return __hip_atomic_load((const unsigned long long*)list + u.e * CAP + rr, __ATOMIC_RELAXED, __HIP_MEMORY_SCOPE_AGENT); }
    __device__ __forceinline__ bool filler_rank(int& rank, int& npart) const {
        const int U = total_units(), W = G / NXCD, mx = max_units(U);
        int tot = 0, myr = -1;
#pragma unroll
        for (int x = 0; x < NXCD; ++x) { int st, n; chunk(U, x, st, n); const int full = n - W * (mx - 1); const int busy = full > 0 ? full : 0;
            if (x == c % NXCD) { const int r = c / NXCD; if (r >= busy) myr = tot + (r - busy); }
            tot += W - busy; }
        if (tot == 0) { rank = c; npart = G; return true; }
        rank = myr; npart = tot; return myr >= 0;
    }
};
template <class Epi, class Sched>
__device__ __forceinline__ void gemm_phase(PG8_LAS unsigned char* lds, const Gemm g, const Sched& S, const Epi& E, int wv, PG8_LAS unsigned long long* tab = nullptr) {
    int tid_ = wv * 64 + hw_lane(); asm volatile("" : "+v"(tid_));
    const int tid = tid_, wid = __builtin_amdgcn_readfirstlane(tid >> 6), lane = tid & 63, wr = wid >> 2, wc = wid & 3, fr = lane & 15, fq = lane >> 4;
    const int K = g.K, nt = K / BK;
    int Rl[2], Cl[2]; unsigned voffB[2];
#pragma unroll
    for (int i = 0; i < 2; ++i) { int R, C; stage_rc(tid * 16 + i * 8192, R, C); const int Rb = Epi::PERM ? ((R & ~31) + perm32(R & 31)) : R;
        Rl[i] = R; Cl[i] = C; voffB[i] = (unsigned)(Rb * K + C) * 2u; }
    const size_t kstep = (size_t)(BK * 2);
    const size_t hstep = (size_t)HALF * K * 2;
    const size_t tstep = 2 * hstep;
    const unsigned ldsw = (unsigned)wid * 1024u;
    const int aoff = lds_byte(wr * 64 + fr, fq * 8), boff = lds_byte(wc * 32 + fr, fq * 8);
#define PG8_SA(b, h) (((b) * 2 + (h)) * HTB)
#define PG8_SB(b, h) ((4 + (b) * 2 + (h)) * HTB)
#define PG8_STAGE(bufoff, gbase, voff) do { _Pragma("unroll") for (int _i = 0; _i < 2; ++_i) \
        __builtin_amdgcn_global_load_lds((const unsigned*)((const char*)(gbase) + (voff)[_i]), (PG8_LAS unsigned*)(lds + (bufoff) + ldsw + _i * 8192), 16, 0, 0); } while (0)
#define PG8_LDA(dst, b, h) do { _Pragma("unroll") for (int m = 0; m < 4; ++m) _Pragma("unroll") for (int k = 0; k < 2; ++k) dst[m][k] = *(const PG8_LAS bf16x8*)(lds + PG8_SA(b, h) + aoff + m * 2048 + k * 1024); } while (0)
#define PG8_LDB(dst, b, h) do { _Pragma("unroll") for (int n = 0; n < 2; ++n) _Pragma("unroll") for (int k = 0; k < 2; ++k) dst[n][k] = *(const PG8_LAS bf16x8*)(lds + PG8_SB(b, h) + boff + n * 2048 + k * 1024); } while (0)
#define PG8_MMA(ai, bj, At, Bt) do { __builtin_amdgcn_s_setprio(1); _Pragma("unroll") for (int m = 0; m < 4; ++m) _Pragma("unroll") for (int n = 0; n < 2; ++n) _Pragma("unroll") for (int k = 0; k < 2; ++k) \
        acc[ai][bj][m][n] = __builtin_amdgcn_mfma_f32_16x16x32_bf16(Bt[n][k], At[m][k], acc[ai][bj][m][n], 0, 0, 0); __builtin_amdgcn_s_setprio(0); } while (0)
#define PG8_WAIT_V(n) asm volatile("s_waitcnt vmcnt(" #n ")" ::: "memory")
#define PG8_WAIT_L(n) asm volatile("s_waitcnt lgkmcnt(" #n ")" ::: "memory")
#define PG8_BAR __builtin_amdgcn_s_barrier()
#define PG8_SCHED __builtin_amdgcn_sched_barrier(0)
#define PG8_AOFF(dst, u) do { _Pragma("unroll") for (int _h = 0; _h < 2; ++_h) _Pragma("unroll") for (int _i = 0; _i < 2; ++_i) \
        dst[_h][_i] = (S.arow(u, _h * HALF + Rl[_i]) * (unsigned)K + (unsigned)Cl[_i]) * 2u; } while (0)
    Unit cur, nxt; int ui = 0;
    if (!S.next(0, cur)) return;
    f32x4 acc[2][2][4][2];
#pragma unroll
    for (int a = 0; a < 2; ++a)
#pragma unroll
        for (int b = 0; b < 2; ++b)
#pragma unroll
            for (int m = 0; m < 4; ++m)
#pragma unroll
                for (int n = 0; n < 2; ++n) acc[a][b][m][n] = (f32x4){0.f, 0.f, 0.f, 0.f};
    bf16x8 At[4][2], B0[2][2], B1[2][2];
    unsigned oA[2][2], oN[2][2];
    PG8_AOFF(oA, cur);
    if (Sched::HAS_TAB) { if (tid < BM) tab[tid] = S.record(cur, tid); }
    const char* const Ab = (const char*)g.A;
    const char* cB = (const char*)g.Bt + ((size_t)cur.e * g.bstride) * 2 + (size_t)cur.pn * tstep;
    PG8_STAGE(PG8_SB(0, 0), cB, voffB); PG8_STAGE(PG8_SB(0, 1), cB + hstep, voffB); PG8_STAGE(PG8_SA(0, 0), Ab, oA[0]); PG8_STAGE(PG8_SA(0, 1), Ab, oA[1]);
    if (wr == 1) PG8_BAR;
    PG8_WAIT_V(2); PG8_BAR;
    PG8_STAGE(PG8_SB(1, 0), cB + kstep, voffB); PG8_STAGE(PG8_SA(1, 0), Ab + kstep, oA[0]); PG8_STAGE(PG8_SB(1, 1), cB + hstep + kstep, voffB);
    PG8_WAIT_V(6); PG8_BAR;
    for (;;) {
        const bool has_next = S.next(ui + 1, nxt);
        if (has_next) { PG8_AOFF(oN, nxt); if (Sched::HAS_TAB) { if (tid < BM) tab[((ui + 1) % 3) * BM + tid] = S.record(nxt, tid); } }
        else {
#pragma unroll
            for (int h = 0; h < 2; ++h)
#pragma unroll
                for (int i = 0; i < 2; ++i) oN[h][i] = oA[h][i];
        }
        const char* nB = has_next ? (const char*)g.Bt + ((size_t)nxt.e * g.bstride) * 2 + (size_t)nxt.pn * tstep : cB;
        for (int t = 0; t < nt; t += 2) {
            const bool last = (t == nt - 2);
            const char* a1 = Ab + (size_t)(t + 1) * kstep;
            const char* a2 = last ? Ab : Ab + (size_t)(t + 2) * kstep; const char* b2 = last ? nB : cB + (size_t)(t + 2) * kstep;
            const char* a3 = a2 + kstep; const char* b3 = b2 + kstep;
            unsigned o2[2][2];
#pragma unroll
            for (int h = 0; h < 2; ++h)
#pragma unroll
                for (int i = 0; i < 2; ++i) o2[h][i] = last ? oN[h][i] : oA[h][i];
            PG8_LDB(B0, 0, 0); PG8_LDB(B1, 0, 1); PG8_SCHED; PG8_LDA(At, 0, 0); PG8_STAGE(PG8_SA(1, 1), a1, oA[1]);
            PG8_WAIT_V(8); PG8_WAIT_L(0); PG8_BAR; PG8_MMA(0, 0, At, B0); PG8_MMA(0, 1, At, B1); PG8_BAR; PG8_SCHED;
            PG8_LDA(At, 0, 1); PG8_STAGE(PG8_SB(0, 0), b2, voffB); PG8_STAGE(PG8_SB(0, 1), b2 + hstep, voffB); PG8_STAGE(PG8_SA(0, 0), a2, o2[0]);
            PG8_WAIT_V(8); PG8_WAIT_L(0); PG8_BAR; PG8_MMA(1, 0, At, B0); PG8_MMA(1, 1, At, B1); PG8_BAR; PG8_SCHED;
            PG8_LDB(B0, 1, 0); PG8_LDB(B1, 1, 1); PG8_SCHED; PG8_LDA(At, 1, 0); PG8_STAGE(PG8_SA(0, 1), a2, o2[1]);
            PG8_WAIT_V(8); PG8_WAIT_L(0); PG8_BAR; PG8_MMA(0, 0, At, B0); PG8_MMA(0, 1, At, B1); PG8_BAR; PG8_SCHED;
            PG8_LDA(At, 1, 1); PG8_STAGE(PG8_SB(1, 0), b3, voffB); PG8_STAGE(PG8_SB(1, 1), b3 + hstep, voffB); PG8_STAGE(PG8_SA(1, 0), a3, o2[0]);
            PG8_WAIT_V(8); PG8_WAIT_L(0); PG8_BAR; PG8_MMA(1, 0, At, B0); PG8_MMA(1, 1, At, B1); PG8_BAR; PG8_SCHED;
        }
        if (wr == 0) PG8_BAR;
        E(acc, cur, wr, wc, fr, fq, tab + (ui % 3) * BM);
        if (!has_next) break;
#pragma unroll
        for (int a = 0; a < 2; ++a)
#pragma unroll
            for (int b = 0; b < 2; ++b)
#pragma unroll
                for (int m = 0; m < 4; ++m)
#pragma unroll
                    for (int n = 0; n < 2; ++n) acc[a][b][m][n] = (f32x4){0.f, 0.f, 0.f, 0.f};
        cur = nxt; cB = nB; ++ui;
#pragma unroll
        for (int h = 0; h < 2; ++h)
#pragma unroll
            for (int i = 0; i < 2; ++i) oA[h][i] = oN[h][i];
        if (wr == 1) PG8_BAR;
    }
    PG8_WAIT_V(0);
    PG8_BAR;
#undef PG8_SA
#undef PG8_SB
#undef PG8_STAGE
#undef PG8_LDA
#undef PG8_LDB
#undef PG8_MMA
#undef PG8_WAIT_V
#undef PG8_WAIT_L
#undef PG8_BAR
#undef PG8_SCHED
#undef PG8_AOFF
}
}
#define GAS __attribute__((address_space(1)))
#define LAS __attribute__((address_space(3)))
typedef unsigned v4u __attribute__((ext_vector_type(4)));
typedef GAS unsigned gu32;
#define RLX_AGENT __ATOMIC_RELAXED, __HIP_MEMORY_SCOPE_AGENT
#define LDS_WAIT() asm volatile("s_waitcnt lgkmcnt(0)" ::: "memory")
#define VM_WAIT() asm volatile("s_waitcnt vmcnt(0)" ::: "memory")
constexpr int NWAVES = 8;
constexpr int RING_OFF = 0, RING_BYTES = 131072;
constexpr int LDSCTL_OFF = RING_BYTES, MISC_OFF = LDSCTL_OFF + 320;
constexpr int LDS_BYTES = 147456;

constexpr size_t WS_WT_EV_IN = WS_END;
constexpr size_t WS_WT_EV_OUT = WS_WT_EV_IN + 10 * MiB;
constexpr size_t WS_WT_OD_IN = WS_WT_EV_OUT + 4 * MiB;
constexpr size_t WS_WT_OD_OUT = WS_WT_OD_IN + 18 * MiB;
constexpr size_t WS_WT_GU = WS_WT_OD_OUT + 4 * MiB;
constexpr size_t WS_WT_DN = WS_WT_GU + 128 * MiB;
constexpr size_t WS_SGUW = WS_WT_DN + 64 * MiB;
constexpr size_t WS_OG = WS_SGUW + 1 * MiB;
constexpr size_t WS_LSE = WS_OG + 48 * MiB;
constexpr size_t WS_XB = WS_LSE + 2 * MiB;
constexpr size_t WS_WRT = WS_XB + 64 * MiB;
constexpr size_t WS_END2 = WS_WRT + 1 * MiB;
constexpr int CW_CNT = 0;
constexpr int CW_BAR = 16384;
constexpr float C2 = 0.125f * 1.4426950408889634f;
constexpr bool FUSE_PROJ_ACT = true;

#define XB_TMO      128
#define XB_XCNT(j)  (256  + 64 * (j))
#define XB_XSUB(j)  (1280 + 64 * (j))
#define XB_XGEN(j)  (2304 + 64 * (j))
#define XB_TOP      3328
#define XB_TOPGEN   3392
#define XCD_BAR_WORDS 3456
#define XB_SPIN_CAP (1u << 18)
__device__ __forceinline__ unsigned xb_ld(unsigned* p)              { return __hip_atomic_load(p, __ATOMIC_RELAXED, __HIP_MEMORY_SCOPE_AGENT); }
__device__ __forceinline__ unsigned xb_add(unsigned* p, unsigned v) { return __hip_atomic_fetch_add(p, v, __ATOMIC_RELAXED, __HIP_MEMORY_SCOPE_AGENT); }
__device__ __forceinline__ unsigned xb_xcc_id() { return (unsigned)__builtin_amdgcn_s_getreg((3 << 11) | 20) & 0xFu; }
#define XB_SPIN(cond, bar) do { unsigned _sp = 0; while (cond) { __builtin_amdgcn_s_sleep(1); \
    if ((++_sp & 255u) == 0u) { if (xb_ld(&(bar)[XB_TMO])) break; if (_sp > XB_SPIN_CAP) { atomicAdd(&(bar)[XB_TMO], 1u); break; } } } } while (0)
struct XcdBarrier { unsigned* bar; unsigned x; volatile LAS unsigned* st; };
__device__ __forceinline__ XcdBarrier xcd_barrier_post(unsigned* bar, volatile LAS unsigned* st, int wv) {
    XcdBarrier b; b.bar = bar; b.x = xb_xcc_id(); b.st = st;
    if (wv == 0 && hw_lane() == 0) (void)xb_add(&bar[XB_XCNT(b.x)], 1u);
    return b;
}
__device__ __forceinline__ void xcd_barrier_complete(unsigned* bar, unsigned x, unsigned& nloc, unsigned& nx) {
    const unsigned G = gridDim.x * gridDim.y * gridDim.z;
    unsigned sum, cnt, mine, sp = 0u;
    for (;;) {
        sum = 0u; cnt = 0u; mine = 0u;
#pragma unroll
        for (unsigned j = 0; j < 16; ++j) { const unsigned c = xb_ld(&bar[XB_XCNT(j)]); sum += c; cnt += (c > 0u) ? 1u : 0u; mine = (j == x) ? c : mine; }
        if (sum == G) break;
        __builtin_amdgcn_s_sleep(1);
        if ((++sp & 255u) == 0u) { if (xb_ld(&bar[XB_TMO])) break; if (sp > XB_SPIN_CAP) { atomicAdd(&bar[XB_TMO], 1u); break; } }
    }
    nloc = mine > 0u ? mine : 1u; nx = cnt > 0u ? cnt : 1u;
}
__device__ __forceinline__ void xcd_barrier(const XcdBarrier& b, int wv) {
    asm volatile("s_waitcnt vmcnt(0)" ::: "memory");
    __syncthreads();
    if (wv == 0 && hw_lane() == 0) {
        unsigned* bar = b.bar;
        __builtin_amdgcn_s_waitcnt(0);
        unsigned nloc = b.st[0], nx = b.st[1];
        if (nloc == 0u) { xcd_barrier_complete(bar, b.x, nloc, nx); b.st[0] = nloc; b.st[1] = nx; }
#ifdef HARD_BAR
        __builtin_amdgcn_fence(__ATOMIC_RELEASE, "agent"); asm volatile("s_waitcnt vmcnt(0)" ::: "memory");
#endif
        const unsigned old = xb_add(&bar[XB_XSUB(b.x)], 1u);
        const unsigned gen = old / nloc;
        if (old + 1u == (gen + 1u) * nloc) {
            __builtin_amdgcn_fence(__ATOMIC_RELEASE, "agent");
            asm volatile("s_waitcnt vmcnt(0)" ::: "memory");
            const unsigned og = xb_add(&bar[XB_TOP], 1u);
            const unsigned tg = og / nx;
            if (og + 1u == (tg + 1u) * nx) xb_add(&bar[XB_TOPGEN], 1u);
            else XB_SPIN(xb_ld(&bar[XB_TOPGEN]) == tg, bar);
            __builtin_amdgcn_fence(__ATOMIC_ACQUIRE, "agent");
            xb_add(&bar[XB_XGEN(b.x)], 1u);
            asm volatile("s_waitcnt vmcnt(0)" ::: "memory");
        } else {
            XB_SPIN(xb_ld(&bar[XB_XGEN(b.x)]) == gen, bar);
            __builtin_amdgcn_fence(__ATOMIC_ACQUIRE, "agent");
            asm volatile("s_waitcnt vmcnt(0)" ::: "memory");
        }
    }
    __syncthreads();
}

__device__ __forceinline__ unsigned pk2(float lo, float hi) { return (unsigned)f2bf(lo) | ((unsigned)f2bf(hi) << 16); }
__device__ __forceinline__ float fast_sigmoid(float x) { return __builtin_amdgcn_rcpf(1.f + __builtin_amdgcn_exp2f(-1.4426950408889634f * x)); }
__device__ __forceinline__ float fast_gelu_tanh(float x) { const float u = 0.7978845608028654f * (x + 0.044715f * x * x * x); return x * fast_sigmoid(2.f * u); }

struct EpiProj {
    static constexpr bool PERM = true;
    bf16_t* O; int ldc; int n_gelu, sc_lo, sc_hi;
    __device__ __forceinline__ void operator()(const f32x4 (&acc)[2][2][4][2], const pg8::Unit& u, int wr, int wc, int fr, int fq, LAS const unsigned long long* tab) const {
        const int mode = (u.pn < n_gelu) ? 1 : ((u.pn >= sc_lo && u.pn < sc_hi) ? 2 : 0);
        const int row0 = u.pm * 256 + wr * 64 + fr, col0 = u.pn * 256 + wc * 32 + 8 * fq;
#pragma unroll
        for (int ai = 0; ai < 2; ++ai)
#pragma unroll
            for (int m = 0; m < 4; ++m) { bf16_t* rowp = O + (size_t)(row0 + ai * 128 + m * 16) * ldc + col0;
#pragma unroll
                for (int bj = 0; bj < 2; ++bj) { f32x4 v0 = acc[ai][bj][m][0], v1 = acc[ai][bj][m][1];
                    if (mode == 1) {
#pragma unroll
                        for (int i = 0; i < 4; ++i) { v0[i] = fast_gelu_tanh(v0[i]); v1[i] = fast_gelu_tanh(v1[i]); }
                    } else if (mode == 2) { v0 = v0 * C2; v1 = v1 * C2; }
                    pg8::u32x4 w; w.x = pg8::cvt_pk_bf16(v0[0], v0[1]); w.y = pg8::cvt_pk_bf16(v0[2], v0[3]); w.z = pg8::cvt_pk_bf16(v1[0], v1[1]); w.w = pg8::cvt_pk_bf16(v1[2], v1[3]);
                    *(pg8::u32x4*)(rowp + bj * 128) = w; } }
    }
};
struct EpiOut {
    static constexpr bool PERM = true;
    const float* base32; const bf16_t* base16; bf16_t* out; const float* g1;
    __device__ __forceinline__ void operator()(const f32x4 (&acc)[2][2][4][2], const pg8::Unit& u, int wr, int wc, int fr, int fq, LAS const unsigned long long* tab) const {
        const int col0 = u.pn * 256 + wc * 32 + 8 * fq; const int b = (u.pm * 256) / SEQ;
        f32x4 gv[2][2];
#pragma unroll
        for (int bj = 0; bj < 2; ++bj)
#pragma unroll
            for (int n = 0; n < 2; ++n) gv[bj][n] = *(const f32x4*)(g1 + b * 6144 + col0 + bj * 128 + n * 4);
#pragma unroll
        for (int ai = 0; ai < 2; ++ai)
#pragma unroll
            for (int m = 0; m < 4; ++m) { const size_t off = (size_t)(u.pm * 256 + ai * 128 + wr * 64 + m * 16 + fr) * DM + col0;
#pragma unroll
                for (int bj = 0; bj < 2; ++bj) {
                    f32x4 b0, b1;
                    if (base32) { b0 = *(const f32x4*)(base32 + off + bj * 128); b1 = *(const f32x4*)(base32 + off + bj * 128 + 4); }
                    else { const pg8::u32x4 r = *(const pg8::u32x4*)(base16 + off + bj * 128);
                        b0 = (f32x4){__uint_as_float(r.x << 16), __uint_as_float(r.x & 0xffff0000u), __uint_as_float(r.y << 16), __uint_as_float(r.y & 0xffff0000u)};
                        b1 = (f32x4){__uint_as_float(r.z << 16), __uint_as_float(r.z & 0xffff0000u), __uint_as_float(r.w << 16), __uint_as_float(r.w & 0xffff0000u)}; }
                    const f32x4 v0 = b0 + gv[bj][0] * acc[ai][bj][m][0], v1 = b1 + gv[bj][1] * acc[ai][bj][m][1];
                    pg8::u32x4 w; w.x = pg8::cvt_pk_bf16(v0[0], v0[1]); w.y = pg8::cvt_pk_bf16(v0[2], v0[3]); w.z = pg8::cvt_pk_bf16(v1[0], v1[1]); w.w = pg8::cvt_pk_bf16(v1[2], v1[3]);
                    *(pg8::u32x4*)(out + off + bj * 128) = w; } }
    }
};
struct EpiGU {
    static constexpr bool PERM = true;
    bf16_t* ACT; const int* list; const float* gates;
    __device__ __forceinline__ void operator()(const f32x4 (&acc)[2][2][4][2], const pg8::Unit& u, int wr, int wc, int fr, int fq, LAS const unsigned long long* tab) const {
        unsigned long long rec[2][4];
#pragma unroll
        for (int ai = 0; ai < 2; ++ai)
#pragma unroll
            for (int m = 0; m < 4; ++m) rec[ai][m] = tab[ai * 128 + wr * 64 + m * 16 + fr];
#pragma unroll
        for (int ai = 0; ai < 2; ++ai)
#pragma unroll
            for (int m = 0; m < 4; ++m) { const int rr = u.pm * 256 + ai * 128 + wr * 64 + m * 16 + fr;
                if (rr < u.cnt) {
                    const int ent = (int)(unsigned)rec[ai][m]; const float gt = __uint_as_float((unsigned)(rec[ai][m] >> 32));
                    float o[8];
#pragma unroll
                    for (int n = 0; n < 2; ++n)
#pragma unroll
                        for (int i = 0; i < 4; ++i) { const float g = acc[ai][0][m][n][i]; o[n * 4 + i] = g * fast_sigmoid(g) * acc[ai][1][m][n][i] * gt; }
                    pg8::u32x4 w; w.x = pg8::cvt_pk_bf16(o[0], o[1]); w.y = pg8::cvt_pk_bf16(o[2], o[3]); w.z = pg8::cvt_pk_bf16(o[4], o[5]); w.w = pg8::cvt_pk_bf16(o[6], o[7]);
                    *(pg8::u32x4*)(ACT + (size_t)ent * EFF + u.pn * 128 + wc * 32 + 8 * fq) = w; } }
    }
};
struct EpiDown {
    static constexpr bool PERM = true;
    bf16_t* YS; const int* list;
    __device__ __forceinline__ void operator()(const f32x4 (&acc)[2][2][4][2], const pg8::Unit& u, int wr, int wc, int fr, int fq, LAS const unsigned long long* tab) const {
        int ents[2][4];
#pragma unroll
        for (int ai = 0; ai < 2; ++ai)
#pragma unroll
            for (int m = 0; m < 4; ++m) ents[ai][m] = (int)(unsigned)tab[ai * 128 + wr * 64 + m * 16 + fr];
#pragma unroll
        for (int ai = 0; ai < 2; ++ai)
#pragma unroll
            for (int m = 0; m < 4; ++m) { const int rr = u.pm * 256 + ai * 128 + wr * 64 + m * 16 + fr;
                if (rr < u.cnt) {
                    bf16_t* rowp = YS + (size_t)ents[ai][m] * DM + u.pn * 256 + wc * 32 + 8 * fq;
#pragma unroll
                    for (int bj = 0; bj < 2; ++bj) { const f32x4 v0 = acc[ai][bj][m][0], v1 = acc[ai][bj][m][1];
                        pg8::u32x4 w; w.x = pg8::cvt_pk_bf16(v0[0], v0[1]); w.y = pg8::cvt_pk_bf16(v0[2], v0[3]); w.z = pg8::cvt_pk_bf16(v1[0], v1[1]); w.w = pg8::cvt_pk_bf16(v1[2], v1[3]);
                        *(pg8::u32x4*)(rowp + bj * 128) = w; } } }
    }
};

struct ConvDesc { const float* W; bf16_t* WT; int K, N, kb, n0, drow0; };
__device__ __forceinline__ void conv_load(const ConvDesc& d, float (&v)[32], int lane) {
    const int k0 = 64 * d.kb;
#pragma unroll
    for (int i = 0; i < 16; ++i) { const int kk = 4 * i + (lane >> 4); const pg8::f32x2 t = *(const pg8::f32x2*)(d.W + (size_t)(k0 + kk) * d.N + d.n0 + 2 * (lane & 15)); v[2 * i] = t.x; v[2 * i + 1] = t.y; }
}
__device__ __forceinline__ void conv_finish(const ConvDesc& d, const float (&v)[32], LAS float* scr, int lane) {
    const int k0 = 64 * d.kb;
#pragma unroll
    for (int i = 0; i < 16; ++i) { const int kk = 4 * i + (lane >> 4); scr[kk * 33 + 2 * (lane & 15)] = v[2 * i]; scr[kk * 33 + 2 * (lane & 15) + 1] = v[2 * i + 1]; }
    LDS_WAIT(); asm volatile("" ::: "memory");
    const int c = lane & 7;
#pragma unroll
    for (int j = 0; j < 4; ++j) { const int n = (lane >> 3) + 8 * j; const LAS float* s = scr + (8 * c) * 33 + n;
        v4u o; o.x = pk2(s[0 * 33], s[1 * 33]); o.y = pk2(s[2 * 33], s[3 * 33]); o.z = pk2(s[4 * 33], s[5 * 33]); o.w = pk2(s[6 * 33], s[7 * 33]);
        *(GAS v4u*)(d.WT + (size_t)(d.drow0 + n) * d.K + k0 + 8 * c) = o; }
    LDS_WAIT(); asm volatile("" ::: "memory");
}
struct Args { const float* in[28]; float* out; unsigned char* ws; int ph_lo, ph_hi, li, pad; };

__device__ __forceinline__ int conv_items_total(int L) { return ((L & 1) ? 16 * 144 : 16 * 80) + 512 + 8192 + 4096; }
__device__ __forceinline__ int conv_b1(int L) { return ((L & 1) ? 16 * 144 : 16 * 80) + 512; }
#ifndef CONV_GU_SPLIT
#define CONV_GU_SPLIT 3072
#endif
__device__ __forceinline__ ConvDesc conv_desc(const Args& a, int L, int it) {
    const int i = L >> 1; const bool ev = (L & 1) == 0;
    const int nb = ev ? 80 : 144, n_in = 16 * nb;
    ConvDesc d;
    if (it < n_in) {
        if (ev) { d.W = a.in[6] + (size_t)i * DM * EVEN_IN; d.WT = (bf16_t*)(a.ws + WS_WT_EV_IN) + (size_t)i * EVEN_IN * DM; d.N = EVEN_IN; }
        else { d.W = a.in[17] + (size_t)i * DM * ODD_IN; d.WT = (bf16_t*)(a.ws + WS_WT_OD_IN) + (size_t)i * ODD_IN * DM; d.N = ODD_IN; }
        d.K = DM; d.kb = it / nb; d.n0 = (it % nb) * 32; d.drow0 = d.n0; return d;
    }
    it -= n_in;
    if (it < 512) { d.W = (ev ? a.in[7] : a.in[18]) + (size_t)i * DM * DM; d.WT = (bf16_t*)(a.ws + (ev ? WS_WT_EV_OUT : WS_WT_OD_OUT)) + (size_t)i * DM * DM; d.K = DM; d.N = DM; d.kb = it / 32; d.n0 = (it % 32) * 32; d.drow0 = d.n0; return d; }
    it -= 512;
    if (it < 8192) { const int mi = L * NEXP + (it >> 9), r = it & 511, n0 = (r % 32) * 32, j = n0 & 511;
        d.W = a.in[25] + (size_t)mi * DM * 1024; d.WT = (bf16_t*)(a.ws + WS_WT_GU) + (size_t)mi * 1024 * DM; d.K = DM; d.N = 1024; d.kb = r / 32; d.n0 = n0;
        d.drow0 = (j >> 7) * 256 + (n0 >= 512 ? 128 : 0) + (j & 127); return d; }
    it -= 8192;
    { const int mi = L * NEXP + (it >> 8), r = it & 255; d.W = a.in[26] + (size_t)mi * EFF * DM; d.WT = (bf16_t*)(a.ws + WS_WT_DN) + (size_t)mi * DM * EFF; d.K = EFF; d.N = DM; d.kb = r / 32; d.n0 = (r % 32) * 32; d.drow0 = d.n0; return d; }
}
__device__ __forceinline__ void conv_run(const Args& a, int L, int first, int stride, int end, LAS float* scr, int lane) {
    for (int it = first; it < end; it += 4 * stride) {
        const bool h1 = it + stride < end, h2 = it + 2 * stride < end, h3 = it + 3 * stride < end;
        const ConvDesc d0 = conv_desc(a, L, it);
        const ConvDesc d1 = conv_desc(a, L, h1 ? it + stride : it);
        const ConvDesc d2 = conv_desc(a, L, h2 ? it + 2 * stride : it);
        const ConvDesc d3 = conv_desc(a, L, h3 ? it + 3 * stride : it);
        float v0[32], v1[32], v2[32], v3[32];
        conv_load(d0, v0, lane);
        if (h1) conv_load(d1, v1, lane);
        if (h2) conv_load(d2, v2, lane);
        if (h3) conv_load(d3, v3, lane);
        asm volatile("" ::: "memory"); __builtin_amdgcn_sched_barrier(0);
        conv_finish(d0, v0, scr, lane);
        if (h1) conv_finish(d1, v1, scr, lane);
        if (h2) conv_finish(d2, v2, scr, lane);
        if (h3) conv_finish(d3, v3, scr, lane);
    }
}
__device__ __forceinline__ void filler_convert(const Args& a, LAS unsigned char* lds, int L, int lo, int hi, bool part, int rank, int npart, int wave) {
#ifdef NO_FILLER
    return;
#endif
    if (!part) return;
    const int lane = hw_lane();
    LAS float* scr = (LAS float*)(lds + RING_OFF + wave * 16384);
    conv_run(a, L, lo + rank * NWAVES + wave, npart * NWAVES, hi, scr, lane);
    __syncthreads();
}
__device__ __forceinline__ void p0_prologue(const Args& a, LAS unsigned char* lds, int tid, int lane, int wave, int G) {
    asm volatile("" : "+v"(tid), "+v"(lane));
    if ((int)blockIdx.x < 96) {
        LAS float* cact = (LAS float*)lds;
        LAS float* part = (LAS float*)(lds + 32768);
        const float* c = a.in[1];
        for (int i = tid; i < NB * DM; i += NWAVES * 64) { const float v = c[i]; cact[i] = v / (1.f + __expf(-v)); }
        __syncthreads();
        const int item = blockIdx.x, l = item / 24, n0 = (item % 24) * 256;
        const float* wp = a.in[4] + (size_t)l * DM * 6144 + (size_t)(128 * wave) * 6144 + n0 + lane * 4;
        f32x4 acc[NB];
#pragma unroll
        for (int b = 0; b < NB; ++b) acc[b] = (f32x4){0.f, 0.f, 0.f, 0.f};
#pragma unroll 8
        for (int k = 0; k < 128; ++k) {
            const f32x4 wv = *(const f32x4*)(wp + (size_t)k * 6144);
#pragma unroll
            for (int b = 0; b < NB; ++b) acc[b] += cact[b * DM + 128 * wave + k] * wv;
        }
#pragma unroll
        for (int b = 0; b < NB; ++b) *(LAS f32x4*)(part + (wave * NB + b) * 256 + lane * 4) = acc[b];
        __syncthreads();
        const int idx = tid * 4, b = idx / 256, col = idx % 256;
        f32x4 s = *(const f32x4*)(a.in[5] + l * 6144 + n0 + col);
#pragma unroll
        for (int w = 0; w < NWAVES; ++w) s += *(LAS f32x4*)(part + (w * NB + b) * 256 + col);
        *(f32x4*)((float*)(a.ws + WS_MOD) + ((size_t)l * NB + b) * 6144 + n0 + col) = s;
        __syncthreads();
    }
    for (int e = blockIdx.x * NWAVES * 64 + tid; e < 2 * 4 * 128 * 128; e += G * NWAVES * 64) { const int tt = (e >> 7) & 127, ss = e & 127; ((bf16_t*)(a.ws + WS_SGUW))[e] = (ss <= tt) ? f2bf(a.in[10][e]) : (bf16_t)0; }
    for (int e = blockIdx.x * NWAVES * 64 + tid; e < 16 * DM; e += G * NWAVES * 64) { const int ee = e >> 10, k = e & 1023; const float w = a.in[23][k * 16 + ee]; const bf16_t hi = f2bf(w);
        ((bf16_t*)(a.ws + WS_WRT))[e] = hi; ((bf16_t*)(a.ws + WS_WRT))[16 * DM + e] = f2bf(w - bf2f(hi)); }
    LAS float* scr = (LAS float*)(lds + RING_OFF + wave * 16384);
    const int gw = blockIdx.x * NWAVES + wave, NGW = G * NWAVES;
#ifndef NO_FILLER
    conv_run(a, 0, gw, NGW, conv_b1(0) + CONV_GU_SPLIT, scr, lane);
#else
    for (int L = 0; L < DEPTH; ++L) conv_run(a, L, gw, NGW, conv_items_total(L), scr, lane);
#endif
    __syncthreads();
}

template <int MODE>
__device__ __forceinline__ void phase_norm1(const float* xin, const bf16_t* Xs, bf16_t* Xo, const bf16_t* YS, const float* g2prev, const float* ng, const float* sc, const float* sh, bf16_t* XN, float* out, int lane, int gw, int NGW) {
    asm volatile("" : "+v"(lane), "+s"(gw));
    for (int row = gw; row < T; row += NGW) {
        const int b = row / SEQ;
        f32x4 v[4]; float ss = 0.f;
#pragma unroll
        for (int j = 0; j < 4; ++j) {
            const int col = j * 256 + lane * 4;
            if (MODE == 0) v[j] = *(const f32x4*)(xin + (size_t)row * DM + col);
            else { const uint2 xr = *(const uint2*)(Xs + (size_t)row * DM + col);
                v[j] = (f32x4){__uint_as_float(xr.x << 16), __uint_as_float(xr.x & 0xffff0000u), __uint_as_float(xr.y << 16), __uint_as_float(xr.y & 0xffff0000u)}; }
            if (MODE >= 1) {
                const f32x4 g = *(const f32x4*)(g2prev + b * 6144 + col);
                const uint2 y0 = *(const uint2*)(YS + (size_t)(2 * row) * DM + col), y1 = *(const uint2*)(YS + (size_t)(2 * row + 1) * DM + col);
                v[j][0] += g[0] * (__uint_as_float(y0.x << 16) + __uint_as_float(y1.x << 16));
                v[j][1] += g[1] * (__uint_as_float(y0.x & 0xffff0000u) + __uint_as_float(y1.x & 0xffff0000u));
                v[j][2] += g[2] * (__uint_as_float(y0.y << 16) + __uint_as_float(y1.y << 16));
                v[j][3] += g[3] * (__uint_as_float(y0.y & 0xffff0000u) + __uint_as_float(y1.y & 0xffff0000u));
            }
            if (MODE == 1) { uint2 o; o.x = pk2(v[j][0], v[j][1]); o.y = pk2(v[j][2], v[j][3]); *(uint2*)(Xo + (size_t)row * DM + col) = o; }
            ss += v[j][0] * v[j][0] + v[j][1] * v[j][1] + v[j][2] * v[j][2] + v[j][3] * v[j][3];
        }
        const float r = rsqrtf(wave_sum(ss) * (1.f / DM) + 1e-6f);
#pragma unroll
        for (int j = 0; j < 4; ++j) {
            const int col = j * 256 + lane * 4;
            const f32x4 g = *(const f32x4*)(ng + col);
            if (MODE == 2) { *(f32x4*)(out + (size_t)row * DM + col) = v[j] * r * g; }
            else {
                const f32x4 s1 = *(const f32x4*)(sc + b * 6144 + col), s0 = *(const f32x4*)(sh + b * 6144 + col);
                const f32x4 h = v[j] * r * g * (1.f + s1) + s0;
                uint2 o; o.x = pk2(h[0], h[1]); o.y = pk2(h[2], h[3]);
                *(uint2*)(XN + (size_t)row * DM + col) = o;
            }
        }
    }
}

constexpr int RT_HP = 2064;
constexpr int RT_WT = 0, RT_COEF = 32 * RT_HP, RT_SS = RT_COEF + 8192, RT_PL = RT_SS + 512, RT_LOG = RT_PL + 8192, RT_CNT = RT_LOG + 64 * 17 * 4 + 256;
typedef short bf16x8r __attribute__((ext_vector_type(8)));
typedef unsigned u32x2r __attribute__((ext_vector_type(2)));
__device__ __forceinline__ void phase_router(LAS unsigned char* lds, const bf16_t* X, const float* ng, const float* sc, const float* sh, const bf16_t* wrt, const float* rb, bf16_t* XN, int* cnt, int* list, float* gates, int wave) {
    const int lane = hw_lane(), tid = wave * 64 + lane;
    LAS int* lcnt = (LAS int*)(lds + RT_CNT); LAS int* lbase = lcnt + 16; LAS int* llist = lcnt + 64; LAS float* lgate = (LAS float*)(llist + 16 * 128);
    LAS float* LOG = (LAS float*)(lds + RT_LOG);
    LAS float* gco = (LAS float*)(lds + RT_COEF); LAS float* sho = gco + DM;
    LAS float* SS = (LAS float*)(lds + RT_SS); LAS float* PL = (LAS float*)(lds + RT_PL);
    const int fr = lane & 15, kg = lane >> 4, rt = wave & 3, kh = wave >> 2;
    for (int c = tid; c < 32 * 128; c += NWAVES * 64) { const int row = c >> 7, ch = c & 127; *(LAS pg8::u32x4*)(lds + RT_WT + row * RT_HP + ch * 16) = *(const pg8::u32x4*)(wrt + (size_t)row * DM + ch * 8); }
    for (int rb0 = blockIdx.x * 64; rb0 < T; rb0 += gridDim.x * 64) {
        const int b = rb0 / SEQ;
        if (tid < 16) lcnt[tid] = 0;
        for (int k = tid; k < DM; k += NWAVES * 64) { gco[k] = ng[k] * (1.f + sc[b * 6144 + k]); sho[k] = sh[b * 6144 + k]; }
        asm volatile("" ::: "memory"); __builtin_amdgcn_sched_barrier(0);
        const int row = rb0 + 16 * rt + fr;
        const bf16_t* xr = X + (size_t)row * DM + 512 * kh + 8 * kg;
        float ssq = 0.f;
        {   pg8::u32x4 xq[16];
#pragma unroll
            for (int s4 = 0; s4 < 16; ++s4) xq[s4] = *(const pg8::u32x4*)(xr + 32 * s4);
#pragma unroll
            for (int s4 = 0; s4 < 16; ++s4)
#pragma unroll
                for (int q = 0; q < 4; ++q) { const float a0 = __uint_as_float(xq[s4][q] << 16), a1 = __uint_as_float(xq[s4][q] & 0xffff0000u); ssq += a0 * a0 + a1 * a1; }
        }
        ssq += __shfl_xor(ssq, 16); ssq += __shfl_xor(ssq, 32);
        if (kg == 0) SS[(rt * 2 + kh) * 16 + fr] = ssq;
        __syncthreads();
        const float r = rsqrtf((SS[(rt * 2 + 0) * 16 + fr] + SS[(rt * 2 + 1) * 16 + fr]) * (1.f / DM) + 1e-6f);
        f32x4 acc = (f32x4){0.f, 0.f, 0.f, 0.f};
        bf16_t* xo = XN + (size_t)row * DM + 512 * kh + 8 * kg;
#pragma unroll 1
        for (int hb = 0; hb < 2; ++hb) {
            pg8::u32x4 xp[8];
#pragma unroll
            for (int s8 = 0; s8 < 8; ++s8) xp[s8] = *(const pg8::u32x4*)(xr + 32 * (8 * hb + s8));
#pragma unroll
            for (int s8 = 0; s8 < 8; ++s8) {
                const int k0 = 512 * kh + 32 * (8 * hb + s8) + 8 * kg;
                const f32x4 g0 = *(LAS const f32x4*)(gco + k0), g1 = *(LAS const f32x4*)(gco + k0 + 4), h0 = *(LAS const f32x4*)(sho + k0), h1 = *(LAS const f32x4*)(sho + k0 + 4);
                float hv[8];
#pragma unroll
                for (int q = 0; q < 4; ++q) { const float a0 = __uint_as_float(xp[s8][q] << 16), a1 = __uint_as_float(xp[s8][q] & 0xffff0000u);
                    const float c0 = q < 2 ? g0[2 * q] : g1[2 * q - 4], c1 = q < 2 ? g0[2 * q + 1] : g1[2 * q - 3], d0 = q < 2 ? h0[2 * q] : h1[2 * q - 4], d1 = q < 2 ? h0[2 * q + 1] : h1[2 * q - 3];
                    hv[2 * q] = a0 * r * c0 + d0; hv[2 * q + 1] = a1 * r * c1 + d1; }
                pg8::u32x4 hi, lo;
#pragma unroll
                for (int q = 0; q < 4; ++q) { hi[q] = pk2(hv[2 * q], hv[2 * q + 1]);
                    lo[q] = pk2(hv[2 * q] - __uint_as_float(hi[q] << 16), hv[2 * q + 1] - __uint_as_float(hi[q] & 0xffff0000u)); }
                *(pg8::u32x4*)(xo + 32 * (8 * hb + s8)) = hi;
                const bf16x8r Ah = __builtin_bit_cast(bf16x8r, hi), Al = __builtin_bit_cast(bf16x8r, lo);
                const bf16x8r Bh = *(LAS const bf16x8r*)(lds + RT_WT + fr * RT_HP + k0 * 2), Bl = *(LAS const bf16x8r*)(lds + RT_WT + (16 + fr) * RT_HP + k0 * 2);
                acc = __builtin_amdgcn_mfma_f32_16x16x32_bf16(Ah, Bh, acc, 0, 0, 0);
                acc = __builtin_amdgcn_mfma_f32_16x16x32_bf16(Ah, Bl, acc, 0, 0, 0);
                acc = __builtin_amdgcn_mfma_f32_16x16x32_bf16(Al, Bh, acc, 0, 0, 0);
            }
        }
#pragma unroll
        for (int i = 0; i < 4; ++i) PL[((rt * 2 + kh) * 16 + 4 * kg + i) * 16 + fr] = acc[i];
        __syncthreads();
        for (int v = tid; v < 64 * 16; v += NWAVES * 64) { const int rr = v >> 4, e = v & 15, t4 = rr >> 4, r16 = rr & 15;
            LOG[rr * 17 + e] = PL[((t4 * 2 + 0) * 16 + r16) * 16 + e] + PL[((t4 * 2 + 1) * 16 + r16) * 16 + e]; }
        __syncthreads();
        if (wave == 0) {
            const int row = rb0 + lane;
            float lg[16], mx = -INFINITY;
#pragma unroll
            for (int e = 0; e < 16; ++e) { lg[e] = LOG[lane * 17 + e]; mx = fmaxf(mx, lg[e]); }
            float sum = 0.f;
#pragma unroll
            for (int e = 0; e < 16; ++e) { lg[e] = __expf(lg[e] - mx); sum += lg[e]; }
            const float inv = 1.f / sum;
            float sel[16];
#pragma unroll
            for (int e = 0; e < 16; ++e) { lg[e] *= inv; sel[e] = lg[e] + rb[e]; }
            int grp = 0; float best = -INFINITY;
#pragma unroll
            for (int g = 0; g < 4; ++g) {
                float m1 = -INFINITY, m2 = -INFINITY;
#pragma unroll
                for (int i = 0; i < 4; ++i) { const float sv = sel[4 * g + i]; if (sv > m1) { m2 = m1; m1 = sv; } else if (sv > m2) m2 = sv; }
                const float gs = m1 + m2;
                if (gs > best) { best = gs; grp = g; }
            }
            float s4[4], p4[4];
#pragma unroll
            for (int i = 0; i < 4; ++i) { s4[i] = 0.f; p4[i] = 0.f; }
#pragma unroll
            for (int g = 0; g < 4; ++g)
#pragma unroll
                for (int i = 0; i < 4; ++i) if (g == grp) { s4[i] = sel[4 * g + i]; p4[i] = lg[4 * g + i]; }
            int i1 = 0; float b1 = s4[0];
#pragma unroll
            for (int i = 1; i < 4; ++i) if (s4[i] > b1) { b1 = s4[i]; i1 = i; }
            int i2 = -1; float b2 = -INFINITY;
#pragma unroll
            for (int i = 0; i < 4; ++i) if (i != i1 && s4[i] > b2) { b2 = s4[i]; i2 = i; }
            float pa = 0.f, pb = 0.f;
#pragma unroll
            for (int i = 0; i < 4; ++i) { if (i == i1) pa = p4[i]; if (i == i2) pb = p4[i]; }
            const int e1 = grp * 4 + i1, e2 = grp * 4 + i2;
            const float gi = 1.f / (pa + pb);
            const int p1 = __hip_atomic_fetch_add(lcnt + e1, 1, __ATOMIC_RELAXED, __HIP_MEMORY_SCOPE_WORKGROUP), p2 = __hip_atomic_fetch_add(lcnt + e2, 1, __ATOMIC_RELAXED, __HIP_MEMORY_SCOPE_WORKGROUP);
            llist[e1 * 128 + p1] = row * 2; llist[e2 * 128 + p2] = row * 2 + 1;
            lgate[e1 * 128 + p1] = pa * gi; lgate[e2 * 128 + p2] = pb * gi;
        }
        __syncthreads();
        if (tid < 16) lbase[tid] = atomicAdd(cnt + tid * CNT_STRIDE, lcnt[tid]);
        __syncthreads();
        for (int idx = tid; idx < 16 * 128; idx += NWAVES * 64) { const int e = idx >> 7, pos = idx & 127; if (pos < lcnt[e]) *(int2*)(list + 2 * (e * CAP + lbase[e] + pos)) = make_int2(llist[idx], __float_as_int(lgate[idx])); }
        __syncthreads();
    }
    __syncthreads();
}

typedef short bf16x8v __attribute__((ext_vector_type(8)));
typedef short s16x4 __attribute__((ext_vector_type(4)));
typedef float f32x16 __attribute__((ext_vector_type(16)));
#define MFMA32(a, b, c) __builtin_amdgcn_mfma_f32_32x32x16_bf16(a, b, c, 0, 0, 0)
__device__ __forceinline__ s16x4 lds_tr4(LAS const unsigned char* p) { return __builtin_bit_cast(s16x4, __builtin_amdgcn_ds_read_tr16_b64_v4i16((LAS s16x4*)p)); }
__device__ __forceinline__ bf16x8v cat8(s16x4 a, s16x4 b) { return (bf16x8v){a[0], a[1], a[2], a[3], b[0], b[1], b[2], b[3]}; }
__device__ __forceinline__ float max3f(float a, float b, float c) { float r; asm("v_max3_f32 %0, %1, %2, %3" : "=v"(r) : "v"(a), "v"(b), "v"(c)); return r; }
typedef float f32x2p __attribute__((ext_vector_type(2)));
__device__ __forceinline__ float xhalf_max(float v) { return fmaxf(v, __shfl_xor(v, 32)); }
__device__ __forceinline__ float xhalf_sum(float v) { return v + __shfl_xor(v, 32); }
__device__ __forceinline__ bf16x8v pack8(float a0, float a1, float a2, float a3, float a4, float a5, float a6, float a7) {
    pg8::u32x4 w; w.x = pg8::cvt_pk_bf16(a0, a1); w.y = pg8::cvt_pk_bf16(a2, a3); w.z = pg8::cvt_pk_bf16(a4, a5); w.w = pg8::cvt_pk_bf16(a6, a7);
    return __builtin_bit_cast(bf16x8v, w);
}

constexpr int DA_KPITCH = 144, DA_VPITCH = 320;
constexpr int DA_KBUF = 64 * DA_KPITCH, DA_VBUF = 64 * DA_VPITCH;
constexpr int DA_K_OFF = 0, DA_V_OFF = 4 * DA_KBUF, DA_END = DA_V_OFF + 2 * DA_VBUF;
constexpr int DA_XPITCH = 528;
static_assert(128 * DA_XPITCH <= DA_END, "exchange overlays the K/V buffers");

__device__ __forceinline__ void diff_attn_unit(LAS unsigned char* lds, const bf16_t* PROJ, bf16_t* MIX, int b, int h, int qblk, float lam, float lam_init, const float* subg, int tid, int lane, int wave) {
    const int m = wave >> 2, qs = wave & 3, ql = lane & 31, hi = lane >> 5;
    const int q0 = qblk * 128 + qs * 32, qpos = q0 + ql;
    const size_t rowb = (size_t)b * SEQ;
    const float slope2 = exp2f(-2.f * (float)(h + 1)) * 1.4426950408889634f;
    bf16x8v Qf[4];
#pragma unroll
    for (int s = 0; s < 4; ++s) Qf[s] = *(const bf16x8v*)(PROJ + (rowb + qpos) * EVEN_IN + 1024 + h * 128 + m * 64 + 16 * s + 8 * hi);
    float tab[16];
#pragma unroll
    for (int r = 0; r < 16; ++r) tab[r] = slope2 * (float)((r & 3) + 8 * (r >> 2));
    f32x16 O[4];
#pragma unroll
    for (int d = 0; d < 4; ++d)
#pragma unroll
        for (int r = 0; r < 16; ++r) O[d][r] = 0.f;
    float m_run = -INFINITY, l_run = 0.f;
    const int krow = tid >> 3, kch = tid & 7, vrow = tid >> 4, vch = tid & 15;
    const bf16_t* gk0 = PROJ + (rowb + krow) * EVEN_IN + 1536 + h * 128 + kch * 8;
    const bf16_t* gv0 = PROJ + (rowb + vrow) * EVEN_IN + 2048 + h * 128 + vch * 8;
    const int lk = krow * DA_KPITCH + kch * 16, lv = vrow * DA_VPITCH + vch * 16;
    const int ntiles = 2 * qblk + 2;
    pg8::u32x4 st[4];
#define DA_LOAD(kt) do { const size_t ro = (size_t)(kt) * 64 * EVEN_IN; st[0] = *(const pg8::u32x4*)(gk0 + ro); st[1] = *(const pg8::u32x4*)(gk0 + ro + 64); \
        st[2] = *(const pg8::u32x4*)(gv0 + ro); st[3] = *(const pg8::u32x4*)(gv0 + ro + (size_t)32 * EVEN_IN); } while (0)
#define DA_STORE(buf) do { *(LAS pg8::u32x4*)(lds + DA_K_OFF + ((buf) * 2 + 0) * DA_KBUF + lk) = st[0]; *(LAS pg8::u32x4*)(lds + DA_K_OFF + ((buf) * 2 + 1) * DA_KBUF + lk) = st[1]; \
        *(LAS pg8::u32x4*)(lds + DA_V_OFF + (buf) * DA_VBUF + lv) = st[2]; *(LAS pg8::u32x4*)(lds + DA_V_OFF + (buf) * DA_VBUF + lv + 32 * DA_VPITCH) = st[3]; } while (0)
    DA_LOAD(0); DA_STORE(0);
    __syncthreads();
    const int kbase = ql * DA_KPITCH + hi * 16;
    const int idx = lane & 15, tq = idx >> 2, tp = idx & 3, g16 = (lane >> 4) & 1;
    const int vbase = (4 * hi + tq) * DA_VPITCH + (16 * g16 + 4 * tp) * 2;
    for (int kt = 0; kt < ntiles; ++kt) {
        const int buf = kt & 1;
        if (kt + 1 < ntiles) DA_LOAD(kt + 1);
        if (64 * kt <= q0 + 31) {
            LAS const unsigned char* kp = lds + DA_K_OFF + (buf * 2 + m) * DA_KBUF + kbase;
            LAS const unsigned char* vp = lds + DA_V_OFF + buf * DA_VBUF + vbase;
            f32x16 S0, S1;
            const float base0 = slope2 * (float)(64 * kt + 4 * hi - qpos), base1 = base0 + slope2 * 32.f;
#pragma unroll
            for (int r = 0; r < 16; ++r) { S0[r] = base0 + tab[r]; S1[r] = base1 + tab[r]; }
#pragma unroll
            for (int s = 0; s < 4; ++s) {
                const bf16x8v a0 = *(LAS const bf16x8v*)(kp + 32 * s), a1 = *(LAS const bf16x8v*)(kp + 32 * s + 32 * DA_KPITCH);
                S0 = MFMA32(a0, Qf[s], S0); S1 = MFMA32(a1, Qf[s], S1);
            }
            if (64 * kt + 63 > q0) {
                const int kb = 64 * kt + 4 * hi;
#pragma unroll
                for (int r = 0; r < 16; ++r) { const int key = kb + (r & 3) + 8 * (r >> 2); if (key > qpos) S0[r] = -INFINITY; if (key + 32 > qpos) S1[r] = -INFINITY; }
            }
            float mxa = max3f(S0[0], S0[1], S1[0]), mxb = max3f(S0[2], S0[3], S1[1]);
            mxa = max3f(mxa, S1[2], S1[3]);
#pragma unroll
            for (int r = 4; r < 16; r += 4) { mxa = max3f(mxa, S0[r], S0[r + 1]); mxb = max3f(mxb, S0[r + 2], S0[r + 3]); mxa = max3f(mxa, S1[r], S1[r + 1]); mxb = max3f(mxb, S1[r + 2], S1[r + 3]); }
            const float mx = xhalf_max(fmaxf(mxa, mxb));
            const float m_new = fmaxf(m_run, mx), alpha = __builtin_amdgcn_exp2f(m_run - m_new);
            m_run = m_new;
            f32x2p ps2 = (f32x2p){0.f, 0.f};
#pragma unroll
            for (int r = 0; r < 16; r += 2) {
                S0[r] = __builtin_amdgcn_exp2f(S0[r] - m_new); S0[r + 1] = __builtin_amdgcn_exp2f(S0[r + 1] - m_new); S1[r] = __builtin_amdgcn_exp2f(S1[r] - m_new); S1[r + 1] = __builtin_amdgcn_exp2f(S1[r + 1] - m_new);
                ps2 += (f32x2p){S0[r], S0[r + 1]}; ps2 += (f32x2p){S1[r], S1[r + 1]};
            }
            const float ps = ps2.x + ps2.y;
            l_run = l_run * alpha + ps;
#pragma unroll
            for (int d = 0; d < 4; ++d)
#pragma unroll
                for (int r = 0; r < 16; ++r) O[d][r] *= alpha;
            bf16x8v Pb[4];
            Pb[0] = pack8(S0[0], S0[1], S0[2], S0[3], S0[4], S0[5], S0[6], S0[7]);
            Pb[1] = pack8(S0[8], S0[9], S0[10], S0[11], S0[12], S0[13], S0[14], S0[15]);
            Pb[2] = pack8(S1[0], S1[1], S1[2], S1[3], S1[4], S1[5], S1[6], S1[7]);
            Pb[3] = pack8(S1[8], S1[9], S1[10], S1[11], S1[12], S1[13], S1[14], S1[15]);
#pragma unroll
            for (int kk = 0; kk < 4; ++kk)
#pragma unroll
                for (int d = 0; d < 4; ++d) {
                    const s16x4 lo = lds_tr4(vp + (16 * kk) * DA_VPITCH + d * 64), hi4 = lds_tr4(vp + (16 * kk + 8) * DA_VPITCH + d * 64);
                    O[d] = MFMA32(cat8(lo, hi4), Pb[kk], O[d]);
                }
        }
        if (kt + 1 < ntiles) DA_STORE(buf ^ 1);
        __syncthreads();
    }
#undef DA_LOAD
#undef DA_STORE
    const float inv = 1.f / xhalf_sum(l_run);
    const float sc = (m == 1) ? inv * lam : inv;
    LAS float* xrow = (LAS float*)(lds + (qs * 32 + ql) * DA_XPITCH);
    if (m == 1) {
#pragma unroll
        for (int d = 0; d < 4; ++d)
#pragma unroll
            for (int g = 0; g < 4; ++g) *(LAS f32x4*)(xrow + 32 * d + 8 * g + 4 * hi) = (f32x4){O[d][4 * g] * sc, O[d][4 * g + 1] * sc, O[d][4 * g + 2] * sc, O[d][4 * g + 3] * sc};
    }
    __syncthreads();
    if (m == 0) {
        float ss = 0.f;
#pragma unroll
        for (int d = 0; d < 4; ++d)
#pragma unroll
            for (int g = 0; g < 4; ++g) { const f32x4 o2 = *(LAS const f32x4*)(xrow + 32 * d + 8 * g + 4 * hi);
#pragma unroll
                for (int i = 0; i < 4; ++i) { const float v = O[d][4 * g + i] * sc - o2[i]; O[d][4 * g + i] = v; ss += v * v; } }
        const float rn = rsqrtf(xhalf_sum(ss) * (1.f / 128.f) + 1e-6f) * (1.f - lam_init);
        bf16_t* orow = MIX + (rowb + qpos) * DM + 512 + h * 128;
#pragma unroll
        for (int d = 0; d < 4; ++d)
#pragma unroll
            for (int g = 0; g < 4; ++g) { const int dd = 32 * d + 8 * g + 4 * hi; const f32x4 sg = *(const f32x4*)(subg + dd);
                uint2 w; w.x = pg8::cvt_pk_bf16(O[d][4 * g] * rn * sg[0], O[d][4 * g + 1] * rn * sg[1]); w.y = pg8::cvt_pk_bf16(O[d][4 * g + 2] * rn * sg[2], O[d][4 * g + 3] * rn * sg[3]);
                *(uint2*)(orow + dd) = w; }
    }
    __syncthreads();
}

constexpr int SG_PITCH = 1024;
__device__ __forceinline__ int sg_addr(int row, int colbytes) { return row * SG_PITCH + ((((colbytes >> 6) ^ (row & 3)) << 6) | (colbytes & 63)); }
__device__ __forceinline__ void sgu_unit(LAS unsigned char* lds, const bf16_t* PROJ, bf16_t* MIX, const bf16_t* Wb, const float* bs, const float* lng, const float* lnb, int b, int c, int lane, int wave) {
    const size_t tok0 = (size_t)b * SEQ + c * 128;
    {
        float gw[8], gb[8];
#pragma unroll
        for (int i = 0; i < 8; ++i) { gw[i] = lng[lane * 8 + i]; gb[i] = lnb[lane * 8 + i]; }
        pg8::u32x4 raws[16];
#pragma unroll
        for (int i = 0; i < 16; ++i) raws[i] = *(const pg8::u32x4*)(PROJ + (tok0 + wave * 16 + i) * EVEN_IN + 512 + lane * 8);
#pragma unroll
        for (int i = 0; i < 16; ++i) {
            const int s = wave * 16 + i;
            const pg8::u32x4 raw = raws[i];
            float v[8];
            v[0] = __uint_as_float(raw.x << 16); v[1] = __uint_as_float(raw.x & 0xffff0000u); v[2] = __uint_as_float(raw.y << 16); v[3] = __uint_as_float(raw.y & 0xffff0000u);
            v[4] = __uint_as_float(raw.z << 16); v[5] = __uint_as_float(raw.z & 0xffff0000u); v[6] = __uint_as_float(raw.w << 16); v[7] = __uint_as_float(raw.w & 0xffff0000u);
            float sm = 0.f;
#pragma unroll
            for (int j = 0; j < 8; ++j) sm += v[j];
            const float mean = wave_sum(sm) * (1.f / 512.f);
            float sq = 0.f;
#pragma unroll
            for (int j = 0; j < 8; ++j) { v[j] -= mean; sq += v[j] * v[j]; }
            const float rstd = rsqrtf(wave_sum(sq) * (1.f / 512.f) + 1e-5f);
#pragma unroll
            for (int j = 0; j < 8; ++j) v[j] = v[j] * rstd * gw[j] + gb[j];
            *(LAS bf16x8v*)(lds + sg_addr(s, lane * 16)) = pack8(v[0], v[1], v[2], v[3], v[4], v[5], v[6], v[7]);
        }
    }
    __syncthreads();
    const int g = wave >> 1, th = wave & 1, tl = lane & 31, hi = lane >> 5;
    const int idx = lane & 15, tq = idx >> 2, tp = idx & 3, g16 = (lane >> 4) & 1;
    for (int t2 = 0; t2 < 2; ++t2) {
        const int tt = 2 * th + t2;
        f32x16 acc[4];
#pragma unroll
        for (int d = 0; d < 4; ++d)
#pragma unroll
            for (int r = 0; r < 16; ++r) acc[d][r] = 0.f;
        const bf16_t* wrow = Wb + ((size_t)g * 128 + 32 * tt + tl) * 128 + 8 * hi;
        const int nks = 2 * (tt + 1);
        for (int ks = 0; ks < nks; ++ks) {
            const bf16x8v bw = *(const bf16x8v*)(wrow + 16 * ks);
            const int r0 = 16 * ks + 8 * hi + tq;
#pragma unroll
            for (int d = 0; d < 4; ++d) {
                const int cb = (g * 128 + 32 * d + 16 * g16 + 4 * tp) * 2;
                const s16x4 lo = lds_tr4(lds + sg_addr(r0, cb)), hi4 = lds_tr4(lds + sg_addr(r0 + 4, cb));
                acc[d] = MFMA32(cat8(lo, hi4), bw, acc[d]);
            }
        }
        const int t = 32 * tt + tl; const size_t tok = tok0 + t;
        const float bias = bs[g * 128 + t];
#pragma unroll
        for (int d = 0; d < 4; ++d)
#pragma unroll
            for (int gg = 0; gg < 4; ++gg) { const int ch = g * 128 + 32 * d + 8 * gg + 4 * hi;
                const uint2 ur = *(const uint2*)(PROJ + tok * EVEN_IN + ch);
                const float u0 = __uint_as_float(ur.x << 16), u1 = __uint_as_float(ur.x & 0xffff0000u), u2 = __uint_as_float(ur.y << 16), u3 = __uint_as_float(ur.y & 0xffff0000u);
                uint2 w; w.x = pg8::cvt_pk_bf16(u0 * (acc[d][4 * gg] + bias), u1 * (acc[d][4 * gg + 1] + bias)); w.y = pg8::cvt_pk_bf16(u2 * (acc[d][4 * gg + 2] + bias), u3 * (acc[d][4 * gg + 3] + bias));
                *(uint2*)(MIX + tok * DM + ch) = w; }
    }
    __syncthreads();
}

__device__ __forceinline__ void phase_even_mixer(const Args& a, LAS unsigned char* lds, int l, int tid, int lane, int wave) {
    asm volatile("" : "+v"(tid), "+v"(lane));
    unsigned char* wsp = a.ws;
    const int i = l >> 1, c = blockIdx.x;
    const bf16_t* PROJ = (const bf16_t*)(wsp + WS_PROJ); bf16_t* MIX = (bf16_t*)(wsp + WS_MIX);
    const float lam_init = (l == 0) ? 0.2f : 0.47071301834305654f;
    const float lam = __expf(wave_sum(a.in[12][i * 64 + lane] * a.in[13][i * 64 + lane])) - __expf(wave_sum(a.in[14][i * 64 + lane] * a.in[15][i * 64 + lane])) + lam_init;
    for (int cc = c; cc < 256; cc += gridDim.x) {
        const int bh = cc & 31, j = cc >> 5, b = bh >> 2, h = bh & 3;
        for (int u = 0; u < 2; ++u) diff_attn_unit(lds, PROJ, MIX, b, h, u ? j : 15 - j, lam, lam_init, a.in[16] + i * 128, tid, lane, wave);
    }
    for (int cc = c; cc < 128; cc += gridDim.x)
        sgu_unit(lds, PROJ, MIX, (const bf16_t*)(wsp + WS_SGUW) + (size_t)i * 4 * 128 * 128, a.in[11] + i * 512, a.in[8] + i * 512, a.in[9] + i * 512, cc >> 4, cc & 15, lane, wave);
}
constexpr int DL_VPITCH = 192, DL_VBUF = 32 * DL_VPITCH;
__device__ __forceinline__ void dil_attn_unit(LAS unsigned char* lds, const bf16_t* PROJ, bf16_t* OG, float* LSE, bf16_t* MIX, int b, int h, int blk, int tid, int lane, int wave) {
    const int ql = lane & 31, hi = lane >> 5;
    const int idx = lane & 15, tq = idx >> 2, tp = idx & 3, g16 = (lane >> 4) & 1;
    const size_t rowb = (size_t)b * SEQ;
    const int blk0 = blk * 512;
    const float slope2 = exp2f(-(float)(h + 1)) * 1.4426950408889634f;
    LAS unsigned char* vl = lds + wave * (2 * DL_VBUF);
    const int vrow = lane >> 3, vch = lane & 7;
    const int vbase = (4 * hi + tq) * DL_VPITCH + (16 * g16 + 4 * tp) * 2;
    for (int it = wave; it < 32; it += NWAVES) {
        const int g = it < 16 ? (it >> 3) : 2, j = it < 16 ? (it & 7) : (it - 16);
        const int nh = (g == 2) ? 1 : 2;
        const int dil = (g == 0) ? 1 : (g == 1 ? 4 : 16);
        const int pbase = blk0 + ((g == 0) ? 64 * j : (g == 1 ? (j & 3) + 256 * (j >> 2) : j));
        bf16x8v Qf[2][4];
#pragma unroll
        for (int hh = 0; hh < 2; ++hh) { const int qp = pbase + dil * (32 * (hh < nh ? hh : 0) + ql); const bf16_t* qrow = PROJ + (rowb + qp) * ODD_IN + g * 512 + h * 64 + 8 * hi;
#pragma unroll
            for (int s = 0; s < 4; ++s) Qf[hh][s] = *(const bf16x8v*)(qrow + 16 * s); }
        f32x16 O[2][2];
#pragma unroll
        for (int hh = 0; hh < 2; ++hh)
#pragma unroll
            for (int d = 0; d < 2; ++d)
#pragma unroll
                for (int r = 0; r < 16; ++r) O[hh][d][r] = 0.f;
        float m_run[2] = {-INFINITY, -INFINITY}, l_run[2] = {0.f, 0.f};
        int c0 = -4;
        while (pbase + dil * 32 * c0 < 0) ++c0;
        const int clast = nh - 1;
        const bf16_t* kcol = PROJ + 1536 + g * 512 + h * 64 + 8 * hi;
        const bf16_t* vcol = PROJ + 3072 + h * 64 + vch * 8;
        bf16x8v kc[4], kn[4]; pg8::u32x4 vn[4];
#define DL_LOADK(dst, c) do { const bf16_t* kr = kcol + (rowb + pbase + dil * (32 * (c) + ql)) * ODD_IN; _Pragma("unroll") for (int s = 0; s < 4; ++s) dst[s] = *(const bf16x8v*)(kr + 16 * s); } while (0)
#define DL_LOADV(c) do { _Pragma("unroll") for (int n = 0; n < 4; ++n) vn[n] = *(const pg8::u32x4*)(vcol + (rowb + pbase + dil * (32 * (c) + vrow + 8 * n)) * ODD_IN); } while (0)
#define DL_STOREV(buf) do { _Pragma("unroll") for (int n = 0; n < 4; ++n) *(LAS pg8::u32x4*)(vl + (buf) * DL_VBUF + (vrow + 8 * n) * DL_VPITCH + vch * 16) = vn[n]; } while (0)
        DL_LOADK(kc, c0); DL_LOADV(c0); DL_STOREV(c0 & 1);
        for (int c = c0; c <= clast; ++c) {
            if (c < clast) { DL_LOADK(kn, c + 1); DL_LOADV(c + 1); }
            LAS const unsigned char* vp = vl + (c & 1) * DL_VBUF + vbase;
#pragma unroll
            for (int hh = 0; hh < 2; ++hh) {
                const int ch = c - hh;
                if (hh < nh && ch >= -4 && ch <= 0) {
                    f32x16 S;
                    const float base = slope2 * (float)(32 * ch + 4 * hi - ql);
#pragma unroll
                    for (int r = 0; r < 16; ++r) S[r] = fmaf(slope2, (float)((r & 3) + 8 * (r >> 2)), base);
#pragma unroll
                    for (int s = 0; s < 4; ++s) S = MFMA32(kc[s], Qf[hh][s], S);
                    if (ch == -4) {
#pragma unroll
                        for (int r = 0; r < 16; ++r) { const int kk = 4 * hi + (r & 3) + 8 * (r >> 2); if (kk < ql) S[r] = -INFINITY; }
                    }
                    if (ch == 0) {
#pragma unroll
                        for (int r = 0; r < 16; ++r) { const int kk = 4 * hi + (r & 3) + 8 * (r >> 2); if (kk > ql) S[r] = -INFINITY; }
                    }
                    float mx = S[0];
#pragma unroll
                    for (int r = 1; r < 16; ++r) mx = fmaxf(mx, S[r]);
                    mx = xhalf_max(mx);
                    const float m_new = fmaxf(m_run[hh], mx), alpha = __builtin_amdgcn_exp2f(m_run[hh] - m_new);
                    m_run[hh] = m_new;
                    float ps = 0.f;
#pragma unroll
                    for (int r = 0; r < 16; ++r) { S[r] = __builtin_amdgcn_exp2f(S[r] - m_new); ps += S[r]; }
                    l_run[hh] = l_run[hh] * alpha + ps;
#pragma unroll
                    for (int d = 0; d < 2; ++d)
#pragma unroll
                        for (int r = 0; r < 16; ++r) O[hh][d][r] *= alpha;
                    bf16x8v Pb[2];
                    Pb[0] = pack8(S[0], S[1], S[2], S[3], S[4], S[5], S[6], S[7]);
                    Pb[1] = pack8(S[8], S[9], S[10], S[11], S[12], S[13], S[14], S[15]);
#pragma unroll
                    for (int ks = 0; ks < 2; ++ks)
#pragma unroll
                        for (int d = 0; d < 2; ++d) {
                            const s16x4 lo = lds_tr4(vp + (16 * ks) * DL_VPITCH + d * 64), hi4 = lds_tr4(vp + (16 * ks + 8) * DL_VPITCH + d * 64);
                            O[hh][d] = MFMA32(cat8(lo, hi4), Pb[ks], O[hh][d]);
                        }
                }
            }
            if (c < clast) {
                DL_STOREV((c + 1) & 1);
#pragma unroll
                for (int s = 0; s < 4; ++s) kc[s] = kn[s];
            }
        }
#undef DL_LOADK
#undef DL_LOADV
#undef DL_STOREV
#pragma unroll
        for (int hh = 0; hh < 2; ++hh) {
            if (hh < nh) {
                const int qp = pbase + dil * (32 * hh + ql);
                const float lt = xhalf_sum(l_run[hh]), inv = 1.f / lt;
                bf16_t* orow = OG + ((size_t)g * T + rowb + qp) * 512 + h * 64;
#pragma unroll
                for (int d = 0; d < 2; ++d)
#pragma unroll
                    for (int gg = 0; gg < 4; ++gg) { uint2 w; w.x = pg8::cvt_pk_bf16(O[hh][d][4 * gg] * inv, O[hh][d][4 * gg + 1] * inv); w.y = pg8::cvt_pk_bf16(O[hh][d][4 * gg + 2] * inv, O[hh][d][4 * gg + 3] * inv);
                        *(uint2*)(orow + 32 * d + 8 * gg + 4 * hi) = w; }
                if (hi == 0) LSE[((size_t)g * T + rowb + qp) * 8 + h] = m_run[hh] + __log2f(lt);
            }
        }
    }
    VM_WAIT();
    __syncthreads();
#pragma unroll
    for (int k8 = 0; k8 < 8; ++k8) { const int id = tid + k8 * (NWAVES * 64);
        const int p = id >> 3, ch = id & 7; const size_t tok = rowb + blk0 + p;
        float ls[3], mxl = -INFINITY;
#pragma unroll
        for (int g = 0; g < 3; ++g) { ls[g] = LSE[((size_t)g * T + tok) * 8 + h]; mxl = fmaxf(mxl, ls[g]); }
        float wsum = 0.f;
#pragma unroll
        for (int g = 0; g < 3; ++g) { ls[g] = __builtin_amdgcn_exp2f(ls[g] - mxl); wsum += ls[g]; }
        const float wi = 1.f / wsum;
        float o[8];
#pragma unroll
        for (int i = 0; i < 8; ++i) o[i] = 0.f;
#pragma unroll
        for (int g = 0; g < 3; ++g) {
            const pg8::u32x4 raw = *(const pg8::u32x4*)(OG + ((size_t)g * T + tok) * 512 + h * 64 + ch * 8);
            const float wg = ls[g] * wi;
            o[0] += wg * __uint_as_float(raw.x << 16); o[1] += wg * __uint_as_float(raw.x & 0xffff0000u); o[2] += wg * __uint_as_float(raw.y << 16); o[3] += wg * __uint_as_float(raw.y & 0xffff0000u);
            o[4] += wg * __uint_as_float(raw.z << 16); o[5] += wg * __uint_as_float(raw.z & 0xffff0000u); o[6] += wg * __uint_as_float(raw.w << 16); o[7] += wg * __uint_as_float(raw.w & 0xffff0000u);
        }
        *(bf16x8v*)(MIX + tok * DM + h * 64 + ch * 8) = pack8(o[0], o[1], o[2], o[3], o[4], o[5], o[6], o[7]);
    }
    __syncthreads();
}

constexpr int CV_ROWS = 94, CV_PITCH = 1024, CV_RED_OFF = 98304;
__device__ __forceinline__ void conv_unit(LAS unsigned char* lds, const bf16_t* PROJ, bf16_t* MIX, const float* cw, const float* cb, const float* lg, const float* lb, int tile, int tid, int lane, int wave) {
    asm volatile("" : "+v"(tid), "+v"(lane));
    const int t0 = tile * 64, s0 = t0 % SEQ;
    {
#pragma unroll
        for (int k = 0; k < 12; ++k) {
            const int id = tid + k * (NWAVES * 64), r = id >> 6, ch = id & 63;
            if (r < CV_ROWS) {
                pg8::u32x4 w = (pg8::u32x4){0u, 0u, 0u, 0u};
                if (s0 - 30 + r >= 0) {
                    const bf16_t* p = PROJ + (size_t)(t0 - 30 + r) * ODD_IN + 3584 + 8 * ch;
                    const pg8::u32x4 av = *(const pg8::u32x4*)p, gv = *(const pg8::u32x4*)(p + 512);
#pragma unroll
                    for (int q = 0; q < 4; ++q) { const float a0 = __uint_as_float(av[q] << 16), a1 = __uint_as_float(av[q] & 0xffff0000u), g0 = __uint_as_float(gv[q] << 16), g1 = __uint_as_float(gv[q] & 0xffff0000u);
                        w[q] = pg8::cvt_pk_bf16(a0 * fast_sigmoid(g0), a1 * fast_sigmoid(g1)); }
                }
                *(LAS pg8::u32x4*)(lds + r * CV_PITCH + ch * 16) = w;
            }
        }
    }
    const int c = tid;
    float w[31];
#pragma unroll
    for (int k = 0; k < 31; ++k) w[k] = cw[k * 512 + c];
    const float bias = cb[c];
    __syncthreads();
    float o[64];
#pragma unroll
    for (int tg = 0; tg < 16; ++tg) {
        float x[34];
#pragma unroll
        for (int r = 0; r < 34; ++r) x[r] = __uint_as_float((unsigned)(*(LAS const unsigned short*)(lds + (4 * tg + r) * CV_PITCH + c * 2)) << 16);
#pragma unroll
        for (int jj = 0; jj < 4; ++jj) {
            float a = bias;
#pragma unroll
            for (int k = 0; k < 31; ++k) a += w[k] * x[jj + k];
            o[4 * tg + jj] = a;
        }
    }
    int rbo = CV_RED_OFF; asm volatile("" : "+v"(rbo));
    LAS float* red = (LAS float*)(lds + rbo);
#pragma unroll
    for (int rd = 0; rd < 2; ++rd) {
        float v[64];
#pragma unroll
        for (int t = 0; t < 32; ++t) { v[2 * t] = o[32 * rd + t]; v[2 * t + 1] = o[32 * rd + t] * o[32 * rd + t]; }
#pragma unroll
        for (int n = 32; n >= 1; n >>= 1) {
            const bool up = (lane & n) != 0;
#pragma unroll
            for (int k = 0; k < n; ++k) { const float keep = up ? v[k + n] : v[k], send = up ? v[k] : v[k + n]; v[k] = keep + __shfl_xor(send, n); }
        }
        red[(wave * 2 + rd) * 64 + lane] = v[0];
    }
    __syncthreads();
    if (tid < 64) {
        float sm = 0.f, sq = 0.f;
#pragma unroll
        for (int wv = 0; wv < 8; ++wv) { sm += red[(wv * 2 + (tid >> 5)) * 64 + 2 * (tid & 31)]; sq += red[(wv * 2 + (tid >> 5)) * 64 + 2 * (tid & 31) + 1]; }
        const float mean = sm * (1.f / 512.f), var = sq * (1.f / 512.f) - mean * mean;
        red[1024 + 2 * tid] = mean; red[1024 + 2 * tid + 1] = rsqrtf(fmaxf(var, 0.f) + 1e-5f);
    }
    __syncthreads();
    const float gq = lg[c], bq = lb[c];
#pragma unroll
    for (int t = 0; t < 64; ++t) {
        const float mean = red[1024 + 2 * t], rstd = red[1024 + 2 * t + 1];
        const float y = (o[t] - mean) * rstd * gq + bq;
        *(LAS unsigned short*)(lds + t * CV_PITCH + c * 2) = f2bf(y * fast_sigmoid(y));
    }
    __syncthreads();
#pragma unroll
    for (int k8 = 0; k8 < 8; ++k8) { const int id = tid + k8 * (NWAVES * 64); const int t = id >> 6, ch = id & 63;
        *(pg8::u32x4*)(MIX + (size_t)(t0 + t) * DM + 512 + ch * 8) = *(LAS const pg8::u32x4*)(lds + t * CV_PITCH + ch * 16); }
    __syncthreads();
}

#ifndef RP_DIL
#define RP_DIL 1
#endif
#ifndef RP_CONV
#define RP_CONV 1
#endif
#ifndef REPEAT
#define REPEAT(n) _Pragma("unroll 1") for (int rep_ = 0; rep_ < (n); ++rep_)
#endif
__device__ __forceinline__ void phase_odd_mixer(const Args& a, LAS unsigned char* lds, int l, int tid, int lane, int wave) {
    asm volatile("" : "+v"(tid), "+v"(lane));
    unsigned char* wsp = a.ws;
    const int i = l >> 1;
    const bf16_t* PROJ = (const bf16_t*)(wsp + WS_PROJ); bf16_t* MIX = (bf16_t*)(wsp + WS_MIX);
    REPEAT(RP_DIL) for (int cc = blockIdx.x; cc < 256; cc += gridDim.x) {
        const int bh = cc & 63, blk = cc >> 6;
        dil_attn_unit(lds, PROJ, (bf16_t*)(wsp + WS_OG), (float*)(wsp + WS_LSE), MIX, bh >> 3, bh & 7, blk, tid, lane, wave);
    }
    REPEAT(RP_CONV) for (int cc = blockIdx.x; cc < 256; cc += gridDim.x)
        conv_unit(lds, PROJ, MIX, a.in[19] + (size_t)i * 31 * 512, a.in[20] + i * 512, a.in[21] + i * 512, a.in[22] + i * 512, cc, tid, lane, wave);
}
#ifndef RP_PRO
#define RP_PRO 1
#endif
#ifndef RP_NORM0
#define RP_NORM0 1
#endif
#ifndef RP_INPROJ
#define RP_INPROJ 1
#endif
#ifndef RP_MIXE
#define RP_MIXE 1
#endif
#ifndef RP_MIXO
#define RP_MIXO 1
#endif
#ifndef RP_OUT0
#define RP_OUT0 1
#endif
#ifndef RP_ROUTER
#define RP_ROUTER 1
#endif
#ifndef RP_GU
#define RP_GU 1
#endif
#ifndef RP_DOWN
#define RP_DOWN 1
#endif
#ifndef RP_COMB
#define RP_COMB 1
#endif
#ifndef RP_BAR
#define RP_BAR 1
#endif
#ifndef REPEAT
#define REPEAT(n) _Pragma("unroll 1") for (int rep_ = 0; rep_ < (n); ++rep_)
#endif
constexpr int N_PHASES = 2 + 7 * DEPTH;

__global__ void __launch_bounds__(NWAVES * 64, 2) mega(Args a) {
    extern __shared__ __attribute__((aligned(16))) unsigned char lds_raw[];
    LAS unsigned char* lds = (LAS unsigned char*)lds_raw;
    volatile LAS unsigned* MISC = (volatile LAS unsigned*)(lds + MISC_OFF);
    const int wave = __builtin_amdgcn_readfirstlane((int)threadIdx.x >> 6), G = gridDim.x;
#define tid (wave * 64 + hw_lane())
#define lane hw_lane()
    const int gw = blockIdx.x * NWAVES + wave, NGW = G * NWAVES;
    unsigned char* ws = a.ws;
    gu32* ctl = (gu32*)(ws + WS_CTL);
    for (int u = tid; u < (LDS_BYTES - LDSCTL_OFF) / 4; u += NWAVES * 64) ((LAS unsigned*)(lds + LDSCTL_OFF))[u] = 0u;
    __syncthreads();
    XcdBarrier bar = xcd_barrier_post((unsigned*)ctl + CW_BAR + a.li * 4096, MISC + 8, wave);
#define IN(k) true
#define SEAM(k) do { if ((k) + 1 < N_PHASES) { REPEAT(RP_BAR) xcd_barrier(bar, wave); } } while (0)

    if (IN(0) || IN(1)) {
    float* MOD = (float*)(ws + WS_MOD); bf16_t* XN = (bf16_t*)(ws + WS_XN);
    if (IN(0)) { REPEAT(RP_PRO) p0_prologue(a, lds, tid, lane, wave, G); SEAM(0); }
    if (IN(1)) { REPEAT(RP_NORM0) phase_norm1<0>(a.in[0], nullptr, nullptr, nullptr, nullptr, a.in[2], MOD + 1 * DM, MOD + 0 * DM, XN, nullptr, lane, gw, NGW); SEAM(1); }
    }
    for (int l = 0; l < DEPTH; ++l) {
        const int pb = 2 + 7 * l, i = l >> 1;
        ctl = (gu32*)(ws + WS_CTL);
        float* MOD = (float*)(ws + WS_MOD); bf16_t* X = (bf16_t*)(ws + WS_X); bf16_t* XB = (bf16_t*)(ws + WS_XB);
        bf16_t* XN = (bf16_t*)(ws + WS_XN); bf16_t* PROJ = (bf16_t*)(ws + WS_PROJ); bf16_t* MIX = (bf16_t*)(ws + WS_MIX);
        bf16_t* ACT = (bf16_t*)(ws + WS_ACT); bf16_t* YS = (bf16_t*)(ws + WS_YS); int* LIST = (int*)(ws + WS_LIST); float* GATE = (float*)(ws + WS_GATE);
        const float* mod = MOD + (size_t)l * NB * 6144;
        int* cnt = (int*)ctl + CW_CNT + l * 16 * CNT_STRIDE;
        if (IN(pb + 0)) {
            const bool ev = (l & 1) == 0;
            pg8::Gemm g{XN, ev ? (const bf16_t*)(ws + WS_WT_EV_IN) + (size_t)i * EVEN_IN * DM : (const bf16_t*)(ws + WS_WT_OD_IN) + (size_t)i * ODD_IN * DM, DM, 0};
            pg8::StaticOrder S; S.init(T, ev ? EVEN_IN : ODD_IN, G, (int)blockIdx.x);
            EpiProj E{PROJ, ev ? EVEN_IN : ODD_IN, (FUSE_PROJ_ACT && ev) ? 4 : 0, FUSE_PROJ_ACT ? (ev ? 4 : 0) : 0, FUSE_PROJ_ACT ? 6 : 0};
            REPEAT(RP_INPROJ) pg8::gemm_phase<EpiProj, pg8::StaticOrder>(lds + RING_OFF, g, S, E, wave);
            { int fr_, fn_; const bool fp_ = S.filler_rank(fr_, fn_); const int b1 = conv_b1(l); filler_convert(a, lds, l, b1 + CONV_GU_SPLIT, b1 + 8192, fp_, fr_, fn_, wave); }
            SEAM(pb + 0);
        }
        if (IN(pb + 1)) {
            if ((l & 1) == 0) { REPEAT(RP_MIXE) phase_even_mixer(a, lds, l, tid, lane, wave); }
            else { REPEAT(RP_MIXO) phase_odd_mixer(a, lds, l, tid, lane, wave); }
            SEAM(pb + 1);
        }
        if (IN(pb + 2)) {
            const bool ev = (l & 1) == 0;
            pg8::Gemm g{MIX, (const bf16_t*)(ws + (ev ? WS_WT_EV_OUT : WS_WT_OD_OUT)) + (size_t)i * DM * DM, DM, 0};
            pg8::StaticOrder S; S.init(T, DM, G, (int)blockIdx.x);
            EpiOut E{l == 0 ? a.in[0] : nullptr, XB, X, mod + 2 * DM};
            REPEAT(RP_OUT0) pg8::gemm_phase<EpiOut, pg8::StaticOrder>(lds + RING_OFF, g, S, E, wave);
            SEAM(pb + 2);
        }
        if (IN(pb + 3)) {
            phase_router(lds, X, a.in[3] + l * DM, mod + 4 * DM, mod + 3 * DM, (const bf16_t*)(ws + WS_WRT), a.in[24], XN, cnt, LIST, GATE, wave);
            REPEAT(RP_ROUTER - 1) phase_router(lds, X, a.in[3] + l * DM, mod + 4 * DM, mod + 3 * DM, (const bf16_t*)(ws + WS_WRT), a.in[24], XN, (int*)ctl + 8192 + l * 16 * CNT_STRIDE, (int*)(ws + WS_OG), (float*)(ws + WS_OG + 2 * MiB), wave);
            SEAM(pb + 3);
        }
        if (IN(pb + 4)) {
            pg8::Gemm g{XN, (const bf16_t*)(ws + WS_WT_GU) + (size_t)l * NEXP * 1024 * DM, DM, (size_t)1024 * DM};
            LAS int* ctab = (LAS int*)(lds + LDSCTL_OFF + 1024);
            { const int t_ = tid; if (t_ < NEXP) ctab[t_] = __hip_atomic_load(cnt + t_ * CNT_STRIDE, RLX_AGENT); } __syncthreads();
            pg8::MoeOrder<1> S{ctab, LIST, 4, G, (int)blockIdx.x};
            EpiGU E{ACT, LIST, GATE};
            REPEAT(RP_GU) pg8::gemm_phase<EpiGU, pg8::MoeOrder<1>>(lds + RING_OFF, g, S, E, wave, (LAS unsigned long long*)(lds + LDSCTL_OFF + 2048));
            { int fr_, fn_; const bool fp_ = S.filler_rank(fr_, fn_); const int b2 = conv_b1(l) + 8192; filler_convert(a, lds, l, b2, b2 + 4096, fp_, fr_, fn_, wave);
              if (l + 1 < DEPTH) filler_convert(a, lds, l + 1, 0, conv_b1(l + 1), fp_, fr_, fn_, wave); }
            SEAM(pb + 4);
        }
        if (IN(pb + 5)) {
            pg8::Gemm g{ACT, (const bf16_t*)(ws + WS_WT_DN) + (size_t)l * NEXP * DM * EFF, EFF, (size_t)DM * EFF};
            LAS int* ctab = (LAS int*)(lds + LDSCTL_OFF + 1024);
            { const int t_ = tid; if (t_ < NEXP) ctab[t_] = __hip_atomic_load(cnt + t_ * CNT_STRIDE, RLX_AGENT); } __syncthreads();
            pg8::MoeOrder<0> S{ctab, LIST, 4, G, (int)blockIdx.x};
            EpiDown E{YS, LIST};
            REPEAT(RP_DOWN) pg8::gemm_phase<EpiDown, pg8::MoeOrder<0>>(lds + RING_OFF, g, S, E, wave, (LAS unsigned long long*)(lds + LDSCTL_OFF + 2048));
            if (l + 1 < DEPTH) { int fr_, fn_; const bool fp_ = S.filler_rank(fr_, fn_); const int b1 = conv_b1(l + 1); filler_convert(a, lds, l + 1, b1, b1 + CONV_GU_SPLIT, fp_, fr_, fn_, wave); }
            SEAM(pb + 5);
        }
        if (IN(pb + 6)) {
            if (l + 1 < DEPTH) REPEAT(RP_COMB) phase_norm1<1>(nullptr, X, XB, YS, mod + 5 * DM, a.in[2] + (l + 1) * DM, mod + NB * 6144 + 1 * DM, mod + NB * 6144 + 0 * DM, XN, nullptr, lane, gw, NGW);
            else REPEAT(RP_COMB) phase_norm1<2>(nullptr, X, nullptr, YS, mod + 5 * DM, a.in[27], nullptr, nullptr, nullptr, a.out, lane, gw, NGW);
            SEAM(pb + 6);
        }
    }
#undef IN
#undef SEAM
#undef tid
#undef lane
}
static void launch_mega(const Args& base, int lo, int hi, int li, int grid, hipStream_t stream) {
    Args a = base; a.ph_lo = lo; a.ph_hi = hi; a.li = li; a.pad = 0;
    hipLaunchKernelGGL(mega, dim3(grid), dim3(NWAVES * 64), LDS_BYTES, stream, a);
}
extern "C" void kernel_launch(void* const* d_in, const int* in_sizes, int n_in, void* d_out, int out_size, void* d_ws, size_t ws_size, hipStream_t stream) {
    static int grid = 0;
    if (grid == 0) {
        if (ws_size < WS_END2 || n_in != 28) { fprintf(stderr, "kernel_launch: workspace too small or wrong inputs: %zu < %zu, n_in %d\n", ws_size, (size_t)WS_END2, n_in); grid = -1; return; }
        int dev = 0, cus = 0;
        if (hipGetDevice(&dev) != hipSuccess || hipDeviceGetAttribute(&cus, hipDeviceAttributeMultiprocessorCount, dev) != hipSuccess) { grid = -1; return; }
        if (hipFuncSetAttribute((const void*)mega, hipFuncAttributeMaxDynamicSharedMemorySize, LDS_BYTES) != hipSuccess) { fprintf(stderr, "kernel_launch: hipFuncSetAttribute failed\n"); grid = -1; return; }
        int per_cu = 0;
        if (hipOccupancyMaxActiveBlocksPerMultiprocessor(&per_cu, (const void*)mega, NWAVES * 64, LDS_BYTES) != hipSuccess || per_cu < 1) fprintf(stderr, "kernel_launch: occupancy query reports %d\n", per_cu);
        (void)hipGetLastError();
        grid = cus;
    }
    if (grid < 0) return;
    const float* sgu_ln_g = (const float*)d_in[8]; const float* sgu_ln_b = (const float*)d_in[9];
    const float* sgu_w = (const float*)d_in[10]; const float* sgu_b = (const float*)d_in[11];
    const float* lam_q1 = (const float*)d_in[12]; const float* lam_k1 = (const float*)d_in[13];
    const float* lam_q2 = (const float*)d_in[14]; const float* lam_k2 = (const float*)d_in[15];
    const float* subln_g = (const float*)d_in[16];
    const float* conv_w = (const float*)d_in[19]; const float* conv_b = (const float*)d_in[20];
    const float* conv_ln_g = (const float*)d_in[21]; const float* conv_ln_b = (const float*)d_in[22];
    unsigned char* ws = (unsigned char*)d_ws;
    bf16_t* PROJ = (bf16_t*)(ws + WS_PROJ); bf16_t* MIX = (bf16_t*)(ws + WS_MIX); bf16_t* VN = (bf16_t*)(ws + WS_VN);

    (void)hipMemsetAsync(ws + WS_CTL, 0, 1 * MiB, stream);
    Args a{};
    for (int i = 0; i < 28; ++i) a.in[i] = (const float*)d_in[i];
    a.out = (float*)d_out; a.ws = ws;
    int li = 0;
    launch_mega(a, 0, N_PHASES, li++, grid, stream);
}
```

```cpp
#include <hip/hip_runtime.h>
#include <stdint.h>
#include <stdio.h>

typedef unsigned short bf16_t;
typedef float f32x4 __attribute__((ext_vector_type(4)));

constexpr int NB = 8, SEQ = 2048, DM = 1024, T = NB * SEQ, DEPTH = 4;
constexpr int EVEN_IN = 2560, ODD_IN = 4608;
constexpr int NEXP = 16, EFF = 512, CAP = 16384;

__device__ __forceinline__ float bf2f(bf16_t v) { return __uint_as_float(((unsigned)v) << 16); }
__device__ __forceinline__ bf16_t f2bf(float f) { unsigned u = __float_as_uint(f); return (bf16_t)((u + 0x7fffu + ((u >> 16) & 1u)) >> 16); }
__device__ __forceinline__ float gelu_tanh(float x) { return 0.5f * x * (1.f + tanhf(0.7978845608028654f * (x + 0.044715f * x * x * x))); }
__device__ __forceinline__ float sigmoidf_(float x) { return 1.f / (1.f + __expf(-x)); }
__device__ __forceinline__ float wave_sum(float v) {
#pragma unroll
    for (int o = 1; o < 64; o <<= 1) v += __shfl_xor(v, o);
    return v;
}
__device__ __forceinline__ float wave_max(float v) {
#pragma unroll
    for (int o = 1; o < 64; o <<= 1) v = fmaxf(v, __shfl_xor(v, o));
    return v;
}
__device__ __forceinline__ float block_sum256(float v, float* red) {
    v = wave_sum(v);
    __syncthreads();
    if ((threadIdx.x & 63) == 0) red[threadIdx.x >> 6] = v;
    __syncthreads();
    return red[0] + red[1] + red[2] + red[3];
}

constexpr size_t MiB = 1u << 20;
constexpr size_t WS_CTL = 0;
constexpr size_t WS_MOD = 1 * MiB;
constexpr size_t WS_X = 2 * MiB;
constexpr size_t WS_XN = WS_X + 64 * MiB;
constexpr size_t WS_PROJ = WS_XN + 32 * MiB;
constexpr size_t WS_MIX = WS_PROJ + 144 * MiB;
constexpr size_t WS_VN = WS_MIX + 32 * MiB;
constexpr size_t WS_ACT = WS_VN + 16 * MiB;
constexpr size_t WS_YS = WS_ACT + 32 * MiB;
constexpr size_t WS_LIST = WS_YS + 64 * MiB;
constexpr size_t WS_GATE = WS_LIST + 1 * MiB;
constexpr size_t WS_END = WS_GATE + 1 * MiB;

__global__ __launch_bounds__(256) void k_mod(const float* __restrict__ c, const float* __restrict__ ada_w, const float* __restrict__ ada_b, float* __restrict__ mod) {
    __shared__ float ca[NB][DM];
    for (int i = threadIdx.x; i < NB * DM; i += 256) { float v = c[i]; ca[i / DM][i % DM] = v * sigmoidf_(v); }
    __syncthreads();
    const int gid = blockIdx.x * 256 + threadIdx.x;
    const int l = gid / 6144, j = gid % 6144;
    const float* w = ada_w + (size_t)l * DM * 6144 + j;
    float acc[NB];
#pragma unroll
    for (int b = 0; b < NB; ++b) acc[b] = 0.f;
    for (int k = 0; k < DM; ++k) {
        const float wv = w[(size_t)k * 6144];
#pragma unroll
        for (int b = 0; b < NB; ++b) acc[b] += ca[b][k] * wv;
    }
    const float bias = ada_b[l * 6144 + j];
#pragma unroll
    for (int b = 0; b < NB; ++b) mod[((size_t)l * NB + b) * 6144 + j] = acc[b] + bias;
}

template <bool FIRST, bool ADDMOE>
__global__ __launch_bounds__(256) void k_norm_mod(const float* __restrict__ xin, float* __restrict__ X, const bf16_t* __restrict__ YS, const float* __restrict__ g2prev,
                                                  const float* __restrict__ ng, const float* __restrict__ sc, const float* __restrict__ sh, bf16_t* __restrict__ XN) {
    const int lane = threadIdx.x & 63, row = blockIdx.x * 4 + (threadIdx.x >> 6), b = row / SEQ;
    f32x4 v[4]; float ss = 0.f;
#pragma unroll
    for (int j = 0; j < 4; ++j) {
        const int col = j * 256 + lane * 4;
        v[j] = *(const f32x4*)((FIRST ? xin : X) + (size_t)row * DM + col);
        if (ADDMOE) {
            const f32x4 g = *(const f32x4*)(g2prev + b * 6144 + col);
            const bf16_t* y0 = YS + (size_t)(2 * row) * DM + col; const bf16_t* y1 = y0 + DM;
#pragma unroll
            for (int i = 0; i < 4; ++i) v[j][i] += g[i] * (bf2f(y0[i]) + bf2f(y1[i]));
        }
        if (FIRST || ADDMOE) *(f32x4*)(X + (size_t)row * DM + col) = v[j];
        ss += v[j][0] * v[j][0] + v[j][1] * v[j][1] + v[j][2] * v[j][2] + v[j][3] * v[j][3];
    }
    const float r = rsqrtf(wave_sum(ss) * (1.f / DM) + 1e-6f);
#pragma unroll
    for (int j = 0; j < 4; ++j) {
        const int col = j * 256 + lane * 4;
        const f32x4 g = *(const f32x4*)(ng + col), s1 = *(const f32x4*)(sc + b * 6144 + col), s0 = *(const f32x4*)(sh + b * 6144 + col);
        bf16_t* o = XN + (size_t)row * DM + col;
#pragma unroll
        for (int i = 0; i < 4; ++i) o[i] = f2bf(v[j][i] * r * g[i] * (1.f + s1[i]) + s0[i]);
    }
}

__global__ __launch_bounds__(256) void k_final(const float* __restrict__ X, const bf16_t* __restrict__ YS, const float* __restrict__ g2prev, const float* __restrict__ fg, float* __restrict__ out) {
    const int lane = threadIdx.x & 63, row = blockIdx.x * 4 + (threadIdx.x >> 6), b = row / SEQ;
    f32x4 v[4]; float ss = 0.f;
#pragma unroll
    for (int j = 0; j < 4; ++j) {
        const int col = j * 256 + lane * 4;
        v[j] = *(const f32x4*)(X + (size_t)row * DM + col);
        const f32x4 g = *(const f32x4*)(g2prev + b * 6144 + col);
        const bf16_t* y0 = YS + (size_t)(2 * row) * DM + col; const bf16_t* y1 = y0 + DM;
#pragma unroll
        for (int i = 0; i < 4; ++i) v[j][i] += g[i] * (bf2f(y0[i]) + bf2f(y1[i]));
        ss += v[j][0] * v[j][0] + v[j][1] * v[j][1] + v[j][2] * v[j][2] + v[j][3] * v[j][3];
    }
    const float r = rsqrtf(wave_sum(ss) * (1.f / DM) + 1e-6f);
#pragma unroll
    for (int j = 0; j < 4; ++j) {
        const int col = j * 256 + lane * 4;
        const f32x4 g = *(const f32x4*)(fg + col);
        f32x4 o;
#pragma unroll
        for (int i = 0; i < 4; ++i) o[i] = v[j][i] * r * g[i];
        *(f32x4*)(out + (size_t)row * DM + col) = o;
    }
}

template <int MODE>
__global__ __launch_bounds__(256) void k_gemm(const bf16_t* __restrict__ A, int lda, const float* __restrict__ Bw, int ldb, int K,
                                              bf16_t* __restrict__ Cb, float* __restrict__ Xf, int ldc, const float* __restrict__ gvec,
                                              const int* __restrict__ list, const int* __restrict__ cnt, const float* __restrict__ gates, size_t bstride) {
    __shared__ float As[16][68];
    __shared__ float Bs[16][64];
    __shared__ float Bs2[16][64];
    __shared__ int rsrc[64];
    const int tid = threadIdx.x, e = blockIdx.z, n0 = blockIdx.x * 64, m0 = blockIdx.y * 64;
    const int count = (MODE >= 2) ? cnt[e] : T;
    if (m0 >= count) return;
    const float* Bp = Bw + ((MODE >= 2) ? (size_t)e * bstride : 0);
    if (tid < 64) { const int r = m0 + tid; int ent = r; if (MODE >= 2) ent = (r < count) ? list[e * CAP + r] : -1; rsrc[tid] = ent; }
    __syncthreads();
    const int ar = tid >> 2, ak = (tid & 3) * 4;
    int aent = rsrc[ar]; int asrc = aent < 0 ? 0 : (MODE == 2 ? (aent >> 1) : aent);
    const bf16_t* ap = A + (size_t)asrc * lda + ak;
    const int bk = tid >> 4, bn = (tid & 15) * 4;
    const int tx = tid & 15, ty = tid >> 4;
    float acc[4][4], acc2[4][4];
#pragma unroll
    for (int i = 0; i < 4; ++i)
#pragma unroll
        for (int j = 0; j < 4; ++j) { acc[i][j] = 0.f; acc2[i][j] = 0.f; }
    for (int k0 = 0; k0 < K; k0 += 16) {
        const uint2 av = *(const uint2*)(ap + k0);
        const f32x4 bv = *(const f32x4*)(Bp + (size_t)(k0 + bk) * ldb + n0 + bn);
        f32x4 bv2 = bv;
        if (MODE == 2) bv2 = *(const f32x4*)(Bp + (size_t)(k0 + bk) * ldb + n0 + bn + EFF);
        __syncthreads();
        As[ak + 0][ar] = __uint_as_float(av.x << 16); As[ak + 1][ar] = __uint_as_float(av.x & 0xffff0000u);
        As[ak + 2][ar] = __uint_as_float(av.y << 16); As[ak + 3][ar] = __uint_as_float(av.y & 0xffff0000u);
        *(f32x4*)&Bs[bk][bn] = bv;
        if (MODE == 2) *(f32x4*)&Bs2[bk][bn] = bv2;
        __syncthreads();
#pragma unroll
        for (int k = 0; k < 16; ++k) {
            const f32x4 a = *(const f32x4*)&As[k][ty * 4];
            const f32x4 b = *(const f32x4*)&Bs[k][tx * 4];
#pragma unroll
            for (int i = 0; i < 4; ++i)
#pragma unroll
                for (int j = 0; j < 4; ++j) acc[i][j] += a[i] * b[j];
            if (MODE == 2) {
                const f32x4 b2 = *(const f32x4*)&Bs2[k][tx * 4];
#pragma unroll
                for (int i = 0; i < 4; ++i)
#pragma unroll
                    for (int j = 0; j < 4; ++j) acc2[i][j] += a[i] * b2[j];
            }
        }
    }
#pragma unroll
    for (int i = 0; i < 4; ++i) {
        const int ent = rsrc[ty * 4 + i];
        if (ent < 0) continue;
        const int col = n0 + tx * 4;
        if (MODE == 0) {
            bf16_t* o = Cb + (size_t)ent * ldc + col;
#pragma unroll
            for (int j = 0; j < 4; ++j) o[j] = f2bf(acc[i][j]);
        } else if (MODE == 1) {
            const int b = ent / SEQ;
            float* o = Xf + (size_t)ent * ldc + col;
#pragma unroll
            for (int j = 0; j < 4; ++j) o[j] += gvec[b * 6144 + col + j] * acc[i][j];
        } else if (MODE == 2) {
            const float gt = gates[ent];
            bf16_t* o = Cb + (size_t)ent * ldc + col;
#pragma unroll
            for (int j = 0; j < 4; ++j) { const float g = acc[i][j]; o[j] = f2bf(g * sigmoidf_(g) * acc2[i][j] * gt); }
        } else {
            bf16_t* o = Cb + (size_t)ent * ldc + col;
#pragma unroll
            for (int j = 0; j < 4; ++j) o[j] = f2bf(acc[i][j]);
        }
    }
}

__global__ __launch_bounds__(256) void k_sgu_pre(const bf16_t* __restrict__ PROJ, const float* __restrict__ lg, const float* __restrict__ lb, bf16_t* __restrict__ VN, int fused) {
    __shared__ float red[4];
    const int tok = blockIdx.x, tid = threadIdx.x;
    float a = bf2f(PROJ[(size_t)tok * EVEN_IN + 512 + tid]), b = bf2f(PROJ[(size_t)tok * EVEN_IN + 768 + tid]);
    if (!fused) { a = gelu_tanh(a); b = gelu_tanh(b); }
    const float mean = block_sum256(a + b, red) * (1.f / 512.f);
    const float da = a - mean, db = b - mean;
    const float var = block_sum256(da * da + db * db, red) * (1.f / 512.f);
    const float r = rsqrtf(var + 1e-5f);
    VN[(size_t)tok * 512 + tid] = f2bf(da * r * lg[tid] + lb[tid]);
    VN[(size_t)tok * 512 + 256 + tid] = f2bf(db * r * lg[256 + tid] + lb[256 + tid]);
}
__global__ __launch_bounds__(256) void k_sgu_mix(const bf16_t* __restrict__ PROJ, const bf16_t* __restrict__ VN, const float* __restrict__ W, const float* __restrict__ bs, bf16_t* __restrict__ MIX, int fused) {
    __shared__ bf16_t vn[128][128];
    const int bc = blockIdx.x, g = blockIdx.y, tid = threadIdx.x;
    const int tok0 = bc * 128;
    for (int i = tid; i < 128 * 128; i += 256) { const int s = i >> 7, d = i & 127; vn[s][d] = VN[(size_t)(tok0 + s) * 512 + g * 128 + d]; }
    __syncthreads();
    const int d = tid & 127, half = tid >> 7;
    for (int t = half; t < 128; t += 2) {
        const float* w = W + ((size_t)g * 128 + t) * 128;
        float acc = 0.f;
        for (int s = 0; s <= t; ++s) acc += w[s] * bf2f(vn[s][d]);
        float u = bf2f(PROJ[(size_t)(tok0 + t) * EVEN_IN + g * 128 + d]); if (!fused) u = gelu_tanh(u);
        MIX[(size_t)(tok0 + t) * DM + g * 128 + d] = f2bf(u * (acc + bs[g * 128 + t]));
    }
}

__global__ __launch_bounds__(128) void k_diff_naive(const bf16_t* __restrict__ PROJ, const float* __restrict__ lq1, const float* __restrict__ lk1, const float* __restrict__ lq2, const float* __restrict__ lk2,
                                                    const float* __restrict__ subg, float lam_init, bf16_t* __restrict__ MIX, int fused) {
    __shared__ float sc[2][2][SEQ];
    const float qsc = fused ? 0.6931471805599453f : 0.125f;
    __shared__ float qs[2][128];
    const int lane = threadIdx.x & 63, w = threadIdx.x >> 6;
    const int idx = blockIdx.x * 2 + w, h = idx & 3, tok = idx >> 2, b = tok / SEQ, qpos = tok % SEQ;
    const float lam = __expf(wave_sum(lq1[lane] * lk1[lane])) - __expf(wave_sum(lq2[lane] * lk2[lane])) + lam_init;
    const float slope = exp2f(-2.f * (float)(h + 1));
    qs[w][lane] = bf2f(PROJ[(size_t)tok * EVEN_IN + 1024 + h * 128 + lane]);
    qs[w][64 + lane] = bf2f(PROJ[(size_t)tok * EVEN_IN + 1024 + h * 128 + 64 + lane]);
    __syncthreads();
    float m0 = -INFINITY, m1 = -INFINITY;
    const int nch = qpos / 64 + 1;
    for (int c = 0; c < nch; ++c) {
        const int key = c * 64 + lane;
        float s0 = -INFINITY, s1 = -INFINITY;
        if (key <= qpos) {
            const bf16_t* kp = PROJ + (size_t)(b * SEQ + key) * EVEN_IN + 1536 + h * 128;
            float a0 = 0.f, a1 = 0.f;
            for (int d = 0; d < 64; ++d) { a0 += qs[w][d] * bf2f(kp[d]); a1 += qs[w][64 + d] * bf2f(kp[64 + d]); }
            const float bias = -slope * (float)(qpos - key);
            s0 = a0 * qsc + bias; s1 = a1 * qsc + bias;
        }
        sc[w][0][key] = s0; sc[w][1][key] = s1;
        m0 = fmaxf(m0, s0); m1 = fmaxf(m1, s1);
    }
    m0 = wave_max(m0); m1 = wave_max(m1);
    float l0 = 0.f, l1 = 0.f;
    for (int c = 0; c < nch; ++c) { const int key = c * 64 + lane; l0 += __expf(sc[w][0][key] - m0); l1 += __expf(sc[w][1][key] - m1); }
    l0 = wave_sum(l0); l1 = wave_sum(l1);
    const float i0 = 1.f / l0, i1 = lam / l1;
    for (int c = 0; c < nch; ++c) { const int key = c * 64 + lane; const float a = __expf(sc[w][0][key] - m0) * i0 - __expf(sc[w][1][key] - m1) * i1; sc[w][0][key] = a; }
    __syncthreads();
    float o0 = 0.f, o1 = 0.f;
    for (int key = 0; key <= qpos; ++key) {
        const float a = sc[w][0][key];
        const unsigned vv = *(const unsigned*)(PROJ + (size_t)(b * SEQ + key) * EVEN_IN + 2048 + h * 128 + 2 * lane);
        o0 += a * __uint_as_float(vv << 16); o1 += a * __uint_as_float(vv & 0xffff0000u);
    }
    const float r = rsqrtf(wave_sum(o0 * o0 + o1 * o1) * (1.f / 128.f) + 1e-6f) * (1.f - lam_init);
    bf16_t* o = MIX + (size_t)tok * DM + 512 + h * 128 + 2 * lane;
    o[0] = f2bf(o0 * r * subg[2 * lane]); o[1] = f2bf(o1 * r * subg[2 * lane + 1]);
}

__global__ __launch_bounds__(256) void k_dil_naive(const bf16_t* __restrict__ PROJ, bf16_t* __restrict__ MIX, int fused) {
    __shared__ float qs[4][3][64];
    const float qsc = fused ? 0.6931471805599453f : 0.125f;
    const int lane = threadIdx.x & 63, w = threadIdx.x >> 6;
    const int idx = blockIdx.x * 4 + w, h = idx & 7, tok = idx >> 3, b = tok / SEQ, t = tok % SEQ;
    const float slope = exp2f(-(float)(h + 1));
#pragma unroll
    for (int g = 0; g < 3; ++g) qs[w][g][lane] = bf2f(PROJ[(size_t)tok * ODD_IN + g * 512 + h * 64 + lane]);
    __syncthreads();
    float p[3][3];
    float mx = -INFINITY;
#pragma unroll
    for (int g = 0; g < 3; ++g) {
        const int dil = (g == 0) ? 1 : (g == 1 ? 4 : 16);
#pragma unroll
        for (int jj = 0; jj < 3; ++jj) {
            const int j = jj * 64 + lane, pos = t - j * dil;
            float s = -INFINITY;
            if (j <= 128 && pos >= 0) {
                const bf16_t* kp = PROJ + (size_t)(b * SEQ + pos) * ODD_IN + 1536 + g * 512 + h * 64;
                float a = 0.f;
                for (int d = 0; d < 64; ++d) a += qs[w][g][d] * bf2f(kp[d]);
                s = a * qsc - slope * (float)j;
            }
            p[g][jj] = s; mx = fmaxf(mx, s);
        }
    }
    mx = wave_max(mx);
    float l = 0.f;
#pragma unroll
    for (int g = 0; g < 3; ++g)
#pragma unroll
        for (int jj = 0; jj < 3; ++jj) { p[g][jj] = __expf(p[g][jj] - mx); l += p[g][jj]; }
    l = wave_sum(l);
    float o = 0.f;
#pragma unroll
    for (int g = 0; g < 3; ++g) {
        const int dil = (g == 0) ? 1 : (g == 1 ? 4 : 16);
#pragma unroll
        for (int jj = 0; jj < 3; ++jj) {
            const int nk = (jj == 2) ? 1 : 64;
            for (int kk = 0; kk < nk; ++kk) {
                const float pk = __shfl(p[g][jj], kk);
                int pos = t - (jj * 64 + kk) * dil; if (pos < 0) pos = 0;
                o += pk * bf2f(PROJ[(size_t)(b * SEQ + pos) * ODD_IN + 3072 + h * 64 + lane]);
            }
        }
    }
    MIX[(size_t)tok * DM + h * 64 + lane] = f2bf(o / l);
}

__global__ __launch_bounds__(256) void k_conv_naive(const bf16_t* __restrict__ PROJ, const float* __restrict__ cw, const float* __restrict__ cb, const float* __restrict__ lg, const float* __restrict__ lb, bf16_t* __restrict__ MIX) {
    __shared__ float red[4];
    const int tok = blockIdx.x, tid = threadIdx.x, t = tok % SEQ;
    float v[2];
#pragma unroll
    for (int i = 0; i < 2; ++i) {
        const int ch = tid + i * 256;
        float acc = cb[ch];
        for (int k = 0; k < 31; ++k) {
            const int tt = t - 30 + k;
            if (tt >= 0) {
                const bf16_t* p = PROJ + (size_t)(tok - 30 + k) * ODD_IN + 3584 + ch;
                acc += cw[k * 512 + ch] * bf2f(p[0]) * sigmoidf_(bf2f(p[512]));
            }
        }
        v[i] = acc;
    }
    const float mean = block_sum256(v[0] + v[1], red) * (1.f / 512.f);
    const float d0 = v[0] - mean, d1 = v[1] - mean;
    const float var = block_sum256(d0 * d0 + d1 * d1, red) * (1.f / 512.f);
    const float r = rsqrtf(var + 1e-5f);
    const float y0 = d0 * r * lg[tid] + lb[tid], y1 = d1 * r * lg[tid + 256] + lb[tid + 256];
    MIX[(size_t)tok * DM + 512 + tid] = f2bf(y0 * sigmoidf_(y0));
    MIX[(size_t)tok * DM + 768 + tid] = f2bf(y1 * sigmoidf_(y1));
}

__global__ __launch_bounds__(256) void k_norm_router(const float* __restrict__ X, const float* __restrict__ ng, const float* __restrict__ sc, const float* __restrict__ sh,
                                                     const float* __restrict__ rw, const float* __restrict__ rb, bf16_t* __restrict__ XN, int* __restrict__ cnt, int* __restrict__ list, float* __restrict__ gates) {
    const int lane = threadIdx.x & 63, row = blockIdx.x * 4 + (threadIdx.x >> 6), b = row / SEQ;
    f32x4 v[4]; float ss = 0.f;
#pragma unroll
    for (int j = 0; j < 4; ++j) {
        const int col = j * 256 + lane * 4;
        v[j] = *(const f32x4*)(X + (size_t)row * DM + col);
        ss += v[j][0] * v[j][0] + v[j][1] * v[j][1] + v[j][2] * v[j][2] + v[j][3] * v[j][3];
    }
    const float r = rsqrtf(wave_sum(ss) * (1.f / DM) + 1e-6f);
    float lg[16];
#pragma unroll
    for (int e = 0; e < 16; ++e) lg[e] = 0.f;
#pragma unroll
    for (int j = 0; j < 4; ++j) {
        const int col = j * 256 + lane * 4;
        const f32x4 g = *(const f32x4*)(ng + col), s1 = *(const f32x4*)(sc + b * 6144 + col), s0 = *(const f32x4*)(sh + b * 6144 + col);
        bf16_t* o = XN + (size_t)row * DM + col;
#pragma unroll
        for (int i = 0; i < 4; ++i) {
            const float hv = v[j][i] * r * g[i] * (1.f + s1[i]) + s0[i];
            o[i] = f2bf(hv);
            const float* wr = rw + (size_t)(col + i) * 16;
#pragma unroll
            for (int q = 0; q < 4; ++q) { const f32x4 wv = *(const f32x4*)(wr + 4 * q); lg[4 * q + 0] += hv * wv[0]; lg[4 * q + 1] += hv * wv[1]; lg[4 * q + 2] += hv * wv[2]; lg[4 * q + 3] += hv * wv[3]; }
        }
    }
    float mx = -INFINITY;
#pragma unroll
    for (int e = 0; e < 16; ++e) { lg[e] = wave_sum(lg[e]); mx = fmaxf(mx, lg[e]); }
    float sum = 0.f;
#pragma unroll
    for (int e = 0; e < 16; ++e) { lg[e] = __expf(lg[e] - mx); sum += lg[e]; }
    const float inv = 1.f / sum;
    float sel[16];
#pragma unroll
    for (int e = 0; e < 16; ++e) { lg[e] *= inv; sel[e] = lg[e] + rb[e]; }
    int grp = 0; float best = -INFINITY;
#pragma unroll
    for (int g = 0; g < 4; ++g) {
        float m1 = -INFINITY, m2 = -INFINITY;
#pragma unroll
        for (int i = 0; i < 4; ++i) { const float s = sel[4 * g + i]; if (s > m1) { m2 = m1; m1 = s; } else if (s > m2) m2 = s; }
        const float gs = m1 + m2;
        if (gs > best) { best = gs; grp = g; }
    }
    float s4[4], p4[4];
#pragma unroll
    for (int i = 0; i < 4; ++i) { s4[i] = 0.f; p4[i] = 0.f; }
#pragma unroll
    for (int g = 0; g < 4; ++g)
#pragma unroll
        for (int i = 0; i < 4; ++i) if (g == grp) { s4[i] = sel[4 * g + i]; p4[i] = lg[4 * g + i]; }
    int i1 = 0; float b1 = s4[0];
#pragma unroll
    for (int i = 1; i < 4; ++i) if (s4[i] > b1) { b1 = s4[i]; i1 = i; }
    int i2 = -1; float b2 = -INFINITY;
#pragma unroll
    for (int i = 0; i < 4; ++i) if (i != i1 && s4[i] > b2) { b2 = s4[i]; i2 = i; }
    float pa = 0.f, pb = 0.f;
#pragma unroll
    for (int i = 0; i < 4; ++i) { if (i == i1) pa = p4[i]; if (i == i2) pb = p4[i]; }
    if (lane == 0) {
        const int e1 = grp * 4 + i1, e2 = grp * 4 + i2;
        const float gi = 1.f / (pa + pb);
        const int p1 = atomicAdd(cnt + e1, 1), p2 = atomicAdd(cnt + e2, 1);
        list[e1 * CAP + p1] = row * 2; list[e2 * CAP + p2] = row * 2 + 1;
        gates[row * 2] = pa * gi; gates[row * 2 + 1] = pb * gi;
    }
}

constexpr int CNT_STRIDE = 64;
__device__ __forceinline__ int hw_lane() { unsigned z = 0u; asm volatile("" : "+v"(z)); return (int)__builtin_amdgcn_mbcnt_hi(~0u, __builtin_amdgcn_mbcnt_lo(~0u, z)); }
namespace pg8 {
#define PG8_LAS __attribute__((address_space(3)))
typedef short bf16x8 __attribute__((ext_vector_type(8)));
typedef unsigned u32x4 __attribute__((ext_vector_type(4)));
typedef float f32x2 __attribute__((ext_vector_type(2)));
constexpr int BM = 256, BK = 64, HALF = 128, HTB = HALF * BK * 2, STAGE_BYTES = 8 * HTB, NXCD = 8, WGM = 2;

__host__ __device__ __forceinline__ int lds_byte(int r, int c) { const int st = (r >> 4) * 2 + (c >> 5), rr = r & 15, cc = c & 31, ob = rr * 64 + cc * 2; return st * 1024 + (ob ^ (((ob >> 9) & 1) << 5)); }
__host__ __device__ __forceinline__ void stage_rc(int b, int& R, int& C) { const int st = b / 1024, sb = b % 1024, swz = sb ^ (((sb >> 9) & 1) << 5); R = (st >> 1) * 16 + swz / 64; C = (st & 1) * 32 + (swz % 64) / 2; }
__host__ __device__ __forceinline__ int perm32(int rho) { const int n = rho >> 4, i = rho & 15; return 8 * (i >> 2) + 4 * n + (i & 3); }

struct Unit { int pm, pn, e, cnt; };
struct Gemm { const bf16_t* A; const bf16_t* Bt; int K; size_t bstride; };

__device__ __forceinline__ unsigned cvt_pk_bf16(float lo, float hi) { unsigned r; asm volatile("v_cvt_pk_bf16_f32 %0, %1, %2" : "=v"(r) : "v"(lo), "v"(hi)); return r; }

struct StaticOrder {
    int nM, nN, nwg, G, c;
    __device__ void init(int M, int N, int G_, int c_) { nM = M / BM; nN = N / BM; nwg = nM * nN; G = G_; c = c_; }
    __device__ __forceinline__ bool next(int i, Unit& u) const {
        const long L = (long)i * G + c; if (L >= nwg) return false;
        int wgid = (int)L; { const int q = nwg / NXCD, r = nwg % NXCD, xcd = wgid % NXCD, off = wgid / NXCD; wgid = (xcd < r ? xcd * (q + 1) : r * (q + 1) + (xcd - r) * q) + off; }
        const int nig = WGM * nN, gid = wgid / nig, fm = gid * WGM, gsz = (nM - fm) < WGM ? (nM - fm) : WGM;
        u.pm = fm + ((wgid % nig) % gsz); u.pn = (wgid % nig) / gsz; u.e = 0; u.cnt = 0; return true;
    }
    __device__ __forceinline__ unsigned arow(const Unit& u, int r) const { return (unsigned)(u.pm * BM + r); }
    static constexpr bool HAS_TAB = false;
    __device__ __forceinline__ unsigned long long record(const Unit&, int) const { return 0ull; }
    __device__ __forceinline__ bool filler_rank(int& rank, int& npart) const { const int rem = nwg % G; if (rem == 0) { rank = c; npart = G; return true; } rank = c - rem; npart = G - rem; return c >= rem; }
};
template <int SHIFT>
struct MoeOrder {
    PG8_LAS const int* cnt; const int* list; int nN, G, c;
    __device__ __forceinline__ int total_units() const { int acc = 0;
#pragma unroll
        for (int j = 0; j < NEXP; ++j) acc += (__builtin_amdgcn_readfirstlane(cnt[j]) + BM - 1) / BM;
        return acc * nN; }
    __device__ __forceinline__ void chunk(int U, int x, int& start, int& n) const { const int q = U / NXCD, rm = U % NXCD; n = q + (x < rm ? 1 : 0); start = x * q + (x < rm ? x : rm); }
    __device__ __forceinline__ int my_units(int U) const { int st, n; chunk(U, c % NXCD, st, n); const int r = c / NXCD, W = G / NXCD; return r < n ? (n - r + W - 1) / W : 0; }
    __device__ __forceinline__ int max_units(int U) const { const int W = G / NXCD, nmax = (U + NXCD - 1) / NXCD; return (nmax + W - 1) / W; }
    __device__ __forceinline__ bool next(int i, Unit& u) const {
        int acc = 0; int cj[NEXP];
#pragma unroll
        for (int j = 0; j < NEXP; ++j) { cj[j] = __builtin_amdgcn_readfirstlane(cnt[j]); acc += (cj[j] + BM - 1) / BM; }
        const int U = acc * nN, W = G / NXCD;
        int st, n; chunk(U, c % NXCD, st, n);
        const int jloc = i * W + c / NXCD;
        if (jloc >= n) return false;
        const int uid = st + jloc, mtg = uid / nN; u.pn = uid % nN;
        int e = 0, base = 0, ce = 0; acc = 0;
#pragma unroll
        for (int j = 0; j < NEXP; ++j) { if (j == e) ce = cj[j]; acc += (cj[j] + BM - 1) / BM; if (mtg >= acc) { e = j + 1; base = acc; } }
        u.e = e; u.pm = mtg - base; u.cnt = ce; return true;
    }
    __device__ __forceinline__ unsigned arow(const Unit& u, int r) const {
        int rr = u.pm * BM + r; rr = rr < u.cnt ? rr : u.cnt - 1;
        const int ent = __hip_atomic_load(list + 2 * (u.e * CAP + rr), __ATOMIC_RELAXED, __HIP_MEMORY_SCOPE_AGENT);
        return (unsigned)(ent >> SHIFT);
    }
    static constexpr bool HAS_TAB = true;
    __device__ __forceinline__ unsigned long long record(const Unit& u, int r) const {
        int rr = u.pm * BM + r; rr = rr < u.cnt ? rr : u.cnt - 1;
        return __hip_atomic_load((const unsigned long long*)list + u.e * CAP + rr, __ATOMIC_RELAXED, __HIP_MEMORY_SCOPE_AGENT); }
    __device__ __forceinline__ bool filler_rank(int& rank, int& npart) const {
        const int U = total_units(), W = G / NXCD, mx = max_units(U);
        int tot = 0, myr = -1;
#pragma unroll
        for (int x = 0; x < NXCD; ++x) { int st, n; chunk(U, x, st, n); const int full = n - W * (mx - 1); const int busy = full > 0 ? full : 0;
            if (x == c % NXCD) { const int r = c / NXCD; if (r >= busy) myr = tot + (r - busy); }
            tot += W - busy; }
        if (tot == 0) { rank = c; npart = G; return true; }
        rank = myr; npart = tot; return myr >= 0;
    }
};
template <class Epi, class Sched>
__device__ __forceinline__ void gemm_phase(PG8_LAS unsigned char* lds, const Gemm g, const Sched& S, const Epi& E, int wv, PG8_LAS unsigned long long* tab = nullptr) {
    int tid_ = wv * 64 + hw_lane(); asm volatile("" : "+v"(tid_));
    const int tid = tid_, wid = __builtin_amdgcn_readfirstlane(tid >> 6), lane = tid & 63, wr = wid >> 2, wc = wid & 3, fr = lane & 15, fq = lane >> 4;
    const int K = g.K, nt = K / BK;
    int Rl[2], Cl[2]; unsigned voffB[2];
#pragma unroll
    for (int i = 0; i < 2; ++i) { int R, C; stage_rc(tid * 16 + i * 8192, R, C); const int Rb = Epi::PERM ? ((R & ~31) + perm32(R & 31)) : R;
        Rl[i] = R; Cl[i] = C; voffB[i] = (unsigned)(Rb * K + C) * 2u; }
    const size_t kstep = (size_t)(BK * 2);
    const size_t hstep = (size_t)HALF * K * 2;
    const size_t tstep = 2 * hstep;
    const unsigned ldsw = (unsigned)wid * 1024u;
    const int aoff = lds_byte(wr * 64 + fr, fq * 8), boff = lds_byte(wc * 32 + fr, fq * 8);
#define PG8_SA(b, h) (((b) * 2 + (h)) * HTB)
#define PG8_SB(b, h) ((4 + (b) * 2 + (h)) * HTB)
#define PG8_STAGE(bufoff, gbase, voff) do { _Pragma("unroll") for (int _i = 0; _i < 2; ++_i) \
        __builtin_amdgcn_global_load_lds((const unsigned*)((const char*)(gbase) + (voff)[_i]), (PG8_LAS unsigned*)(lds + (bufoff) + ldsw + _i * 8192), 16, 0, 0); } while (0)
#define PG8_LDA(dst, b, h) do { _Pragma("unroll") for (int m = 0; m < 4; ++m) _Pragma("unroll") for (int k = 0; k < 2; ++k) dst[m][k] = *(const PG8_LAS bf16x8*)(lds + PG8_SA(b, h) + aoff + m * 2048 + k * 1024); } while (0)
#define PG8_LDB(dst, b, h) do { _Pragma("unroll") for (int n = 0; n < 2; ++n) _Pragma("unroll") for (int k = 0; k < 2; ++k) dst[n][k] = *(const PG8_LAS bf16x8*)(lds + PG8_SB(b, h) + boff + n * 2048 + k * 1024); } while (0)
#define PG8_MMA(ai, bj, At, Bt) do { __builtin_amdgcn_s_setprio(1); _Pragma("unroll") for (int m = 0; m < 4; ++m) _Pragma("unroll") for (int n = 0; n < 2; ++n) _Pragma("unroll") for (int k = 0; k < 2; ++k) \
        acc[ai][bj][m][n] = __builtin_amdgcn_mfma_f32_16x16x32_bf16(Bt[n][k], At[m][k], acc[ai][bj][m][n], 0, 0, 0); __builtin_amdgcn_s_setprio(0); } while (0)
#define PG8_WAIT_V(n) asm volatile("s_waitcnt vmcnt(" #n ")" ::: "memory")
#define PG8_WAIT_L(n) asm volatile("s_waitcnt lgkmcnt(" #n ")" ::: "memory")
#define PG8_BAR __builtin_amdgcn_s_barrier()
#define PG8_SCHED __builtin_amdgcn_sched_barrier(0)
#define PG8_AOFF(dst, u) do { _Pragma("unroll") for (int _h = 0; _h < 2; ++_h) _Pragma("unroll") for (int _i = 0; _i < 2; ++_i) \
        dst[_h][_i] = (S.arow(u, _h * HALF + Rl[_i]) * (unsigned)K + (unsigned)Cl[_i]) * 2u; } while (0)
    Unit cur, nxt; int ui = 0;
    if (!S.next(0, cur)) return;
    f32x4 acc[2][2][4][2];
#pragma unroll
    for (int a = 0; a < 2; ++a)
#pragma unroll
        for (int b = 0; b < 2; ++b)
#pragma unroll
            for (int m = 0; m < 4; ++m)
#pragma unroll
                for (int n = 0; n < 2; ++n) acc[a][b][m][n] = (f32x4){0.f, 0.f, 0.f, 0.f};
    bf16x8 At[4][2], B0[2][2], B1[2][2];
    unsigned oA[2][2], oN[2][2];
    PG8_AOFF(oA, cur);
    if (Sched::HAS_TAB) { if (tid < BM) tab[tid] = S.record(cur, tid); }
    const char* const Ab = (const char*)g.A;
    const char* cB = (const char*)g.Bt + ((size_t)cur.e * g.bstride) * 2 + (size_t)cur.pn * tstep;
    PG8_STAGE(PG8_SB(0, 0), cB, voffB); PG8_STAGE(PG8_SB(0, 1), cB + hstep, voffB); PG8_STAGE(PG8_SA(0, 0), Ab, oA[0]); PG8_STAGE(PG8_SA(0, 1), Ab, oA[1]);
    if (wr == 1) PG8_BAR;
    PG8_WAIT_V(2); PG8_BAR;
    PG8_STAGE(PG8_SB(1, 0), cB + kstep, voffB); PG8_STAGE(PG8_SA(1, 0), Ab + kstep, oA[0]); PG8_STAGE(PG8_SB(1, 1), cB + hstep + kstep, voffB);
    PG8_WAIT_V(6); PG8_BAR;
    for (;;) {
        const bool has_next = S.next(ui + 1, nxt);
        if (has_next) { PG8_AOFF(oN, nxt); if (Sched::HAS_TAB) { if (tid < BM) tab[((ui + 1) % 3) * BM + tid] = S.record(nxt, tid); } }
        else {
#pragma unroll
            for (int h = 0; h < 2; ++h)
#pragma unroll
                for (int i = 0; i < 2; ++i) oN[h][i] = oA[h][i];
        }
        const char* nB = has_next ? (const char*)g.Bt + ((size_t)nxt.e * g.bstride) * 2 + (size_t)nxt.pn * tstep : cB;
        for (int t = 0; t < nt; t += 2) {
            const bool last = (t == nt - 2);
            const char* a1 = Ab + (size_t)(t + 1) * kstep;
            const char* a2 = last ? Ab : Ab + (size_t)(t + 2) * kstep; const char* b2 = last ? nB : cB + (size_t)(t + 2) * kstep;
            const char* a3 = a2 + kstep; const char* b3 = b2 + kstep;
            unsigned o2[2][2];
#pragma unroll
            for (int h = 0; h < 2; ++h)
#pragma unroll
                for (int i = 0; i < 2; ++i) o2[h][i] = last ? oN[h][i] : oA[h][i];
            PG8_LDB(B0, 0, 0); PG8_LDB(B1, 0, 1); PG8_SCHED; PG8_LDA(At, 0, 0); PG8_STAGE(PG8_SA(1, 1), a1, oA[1]);
            PG8_WAIT_V(8); PG8_WAIT_L(0); PG8_BAR; PG8_MMA(0, 0, At, B0); PG8_MMA(0, 1, At, B1); PG8_BAR; PG8_SCHED;
            PG8_LDA(At, 0, 1); PG8_STAGE(PG8_SB(0, 0), b2, voffB); PG8_STAGE(PG8_SB(0, 1), b2 + hstep, voffB); PG8_STAGE(PG8_SA(0, 0), a2, o2[0]);
            PG8_WAIT_V(8); PG8_WAIT_L(0); PG8_BAR; PG8_MMA(1, 0, At, B0); PG8_MMA(1, 1, At, B1); PG8_BAR; PG8_SCHED;
            PG8_LDB(B0, 1, 0); PG8_LDB(B1, 1, 1); PG8_SCHED; PG8_LDA(At, 1, 0); PG8_STAGE(PG8_SA(0, 1), a2, o2[1]);
            PG8_WAIT_V(8); PG8_WAIT_L(0); PG8_BAR; PG8_MMA(0, 0, At, B0); PG8_MMA(0, 1, At, B1); PG8_BAR; PG8_SCHED;
            PG8_LDA(At, 1, 1); PG8_STAGE(PG8_SB(1, 0), b3, voffB); PG8_STAGE(PG8_SB(1, 1), b3 + hstep, voffB); PG8_STAGE(PG8_SA(1, 0), a3, o2[0]);
            PG8_WAIT_V(8); PG8_WAIT_L(0); PG8_BAR; PG8_MMA(1, 0, At, B0); PG8_MMA(1, 1, At, B1); PG8_BAR; PG8_SCHED;
        }
        if (wr == 0) PG8_BAR;
        E(acc, cur, wr, wc, fr, fq, tab + (ui % 3) * BM);
        if (!has_next) break;
#pragma unroll
        for (int a = 0; a < 2; ++a)
#pragma unroll
            for (int b = 0; b < 2; ++b)
#pragma unroll
                for (int m = 0; m < 4; ++m)
#pragma unroll
                    for (int n = 0; n < 2; ++n) acc[a][b][m][n] = (f32x4){0.f, 0.f, 0.f, 0.f};
        cur = nxt; cB = nB; ++ui;
#pragma unroll
        for (int h = 0; h < 2; ++h)
#pragma unroll
            for (int i = 0; i < 2; ++i) oA[h][i] = oN[h][i];
        if (wr == 1) PG8_BAR;
    }
    PG8_WAIT_V(0);
    PG8_BAR;
#undef PG8_SA
#undef PG8_SB
#undef PG8_STAGE
#undef PG8_LDA
#undef PG8_LDB
#undef PG8_MMA
#undef PG8_WAIT_V
#undef PG8_WAIT_L
#undef PG8_BAR
#undef PG8_SCHED
#undef PG8_AOFF
}
}
#define GAS __attribute__((address_space(1)))
#define LAS __attribute__((address_space(3)))
typedef unsigned v4u __attribute__((ext_vector_type(4)));
typedef GAS unsigned gu32;
#define RLX_AGENT __ATOMIC_RELAXED, __HIP_MEMORY_SCOPE_AGENT
#define LDS_WAIT() asm volatile("s_waitcnt lgkmcnt(0)" ::: "memory")
#define VM_WAIT() asm volatile("s_waitcnt vmcnt(0)" ::: "memory")
constexpr int NWAVES = 8;
constexpr int RING_OFF = 0, RING_BYTES = 131072;
constexpr int LDSCTL_OFF = RING_BYTES, MISC_OFF = LDSCTL_OFF + 320;
constexpr int LDS_BYTES = 147456;

constexpr size_t WS_WT_EV_IN = WS_END;
constexpr size_t WS_WT_EV_OUT = WS_WT_EV_IN + 10 * MiB;
constexpr size_t WS_WT_OD_IN = WS_WT_EV_OUT + 4 * MiB;
constexpr size_t WS_WT_OD_OUT = WS_WT_OD_IN + 18 * MiB;
constexpr size_t WS_WT_GU = WS_WT_OD_OUT + 4 * MiB;
constexpr size_t WS_WT_DN = WS_WT_GU + 128 * MiB;
constexpr size_t WS_SGUW = WS_WT_DN + 64 * MiB;
constexpr size_t WS_OG = WS_SGUW + 1 * MiB;
constexpr size_t WS_LSE = WS_OG + 48 * MiB;
constexpr size_t WS_XB = WS_LSE + 2 * MiB;
constexpr size_t WS_WRT = WS_XB + 64 * MiB;
constexpr size_t WS_END2 = WS_WRT + 1 * MiB;
constexpr int CW_CNT = 0;
constexpr int CW_BAR = 16384;
constexpr float C2 = 0.125f * 1.4426950408889634f;
constexpr bool FUSE_PROJ_ACT = true;

#define XB_TMO      128
#define XB_XCNT(j)  (256  + 64 * (j))
#define XB_XSUB(j)  (1280 + 64 * (j))
#define XB_XGEN(j)  (2304 + 64 * (j))
#define XB_TOP      3328
#define XB_TOPGEN   3392
#define XCD_BAR_WORDS 3456
#define XB_SPIN_CAP (1u << 18)
__device__ __forceinline__ unsigned xb_ld(unsigned* p)              { return __hip_atomic_load(p, __ATOMIC_RELAXED, __HIP_MEMORY_SCOPE_AGENT); }
__device__ __forceinline__ unsigned xb_add(unsigned* p, unsigned v) { return __hip_atomic_fetch_add(p, v, __ATOMIC_RELAXED, __HIP_MEMORY_SCOPE_AGENT); }
__device__ __forceinline__ unsigned xb_xcc_id() { return (unsigned)__builtin_amdgcn_s_getreg((3 << 11) | 20) & 0xFu; }
#define XB_SPIN(cond, bar) do { unsigned _sp = 0; while (cond) { __builtin_amdgcn_s_sleep(1); \
    if ((++_sp & 255u) == 0u) { if (xb_ld(&(bar)[XB_TMO])) break; if (_sp > XB_SPIN_CAP) { atomicAdd(&(bar)[XB_TMO], 1u); break; } } } } while (0)
struct XcdBarrier { unsigned* bar; unsigned x; volatile LAS unsigned* st; };
__device__ __forceinline__ XcdBarrier xcd_barrier_post(unsigned* bar, volatile LAS unsigned* st, int wv) {
    XcdBarrier b; b.bar = bar; b.x = xb_xcc_id(); b.st = st;
    if (wv == 0 && hw_lane() == 0) (void)xb_add(&bar[XB_XCNT(b.x)], 1u);
    return b;
}
__device__ __forceinline__ void xcd_barrier_complete(unsigned* bar, unsigned x, unsigned& nloc, unsigned& nx) {
    const unsigned G = gridDim.x * gridDim.y * gridDim.z;
    unsigned sum, cnt, mine, sp = 0u;
    for (;;) {
        sum = 0u; cnt = 0u; mine = 0u;
#pragma unroll
        for (unsigned j = 0; j < 16; ++j) { const unsigned c = xb_ld(&bar[XB_XCNT(j)]); sum += c; cnt += (c > 0u) ? 1u : 0u; mine = (j == x) ? c : mine; }
        if (sum == G) break;
        __builtin_amdgcn_s_sleep(1);
        if ((++sp & 255u) == 0u) { if (xb_ld(&bar[XB_TMO])) break; if (sp > XB_SPIN_CAP) { atomicAdd(&bar[XB_TMO], 1u); break; } }
    }
    nloc = mine > 0u ? mine : 1u; nx = cnt > 0u ? cnt : 1u;
}
__device__ __forceinline__ void xcd_barrier(const XcdBarrier& b, int wv) {
    asm volatile("s_waitcnt vmcnt(0)" ::: "memory");
    __syncthreads();
    if (wv == 0 && hw_lane() == 0) {
        unsigned* bar = b.bar;
        __builtin_amdgcn_s_waitcnt(0);
        unsigned nloc = b.st[0], nx = b.st[1];
        if (nloc == 0u) { xcd_barrier_complete(bar, b.x, nloc, nx); b.st[0] = nloc; b.st[1] = nx; }
#ifdef HARD_BAR
        __builtin_amdgcn_fence(__ATOMIC_RELEASE, "agent"); asm volatile("s_waitcnt vmcnt(0)" ::: "memory");
#endif
        const unsigned old = xb_add(&bar[XB_XSUB(b.x)], 1u);
        const unsigned gen = old / nloc;
        if (old + 1u == (gen + 1u) * nloc) {
            __builtin_amdgcn_fence(__ATOMIC_RELEASE, "agent");
            asm volatile("s_waitcnt vmcnt(0)" ::: "memory");
            const unsigned og = xb_add(&bar[XB_TOP], 1u);
            const unsigned tg = og / nx;
            if (og + 1u == (tg + 1u) * nx) xb_add(&bar[XB_TOPGEN], 1u);
            else XB_SPIN(xb_ld(&bar[XB_TOPGEN]) == tg, bar);
            __builtin_amdgcn_fence(__ATOMIC_ACQUIRE, "agent");
            xb_add(&bar[XB_XGEN(b.x)], 1u);
            asm volatile("s_waitcnt vmcnt(0)" ::: "memory");
        } else {
            XB_SPIN(xb_ld(&bar[XB_XGEN(b.x)]) == gen, bar);
            __builtin_amdgcn_fence(__ATOMIC_ACQUIRE, "agent");
            asm volatile("s_waitcnt vmcnt(0)" ::: "memory");
        }
    }
    __syncthreads();
}

__device__ __forceinline__ unsigned pk2(float lo, float hi) { return (unsigned)f2bf(lo) | ((unsigned)f2bf(hi) << 16); }
__device__ __forceinline__ float fast_sigmoid(float x) { return __builtin_amdgcn_rcpf(1.f + __builtin_amdgcn_exp2f(-1.4426950408889634f * x)); }
__device__ __forceinline__ float fast_gelu_tanh(float x) { const float u = 0.7978845608028654f * (x + 0.044715f * x * x * x); return x * fast_sigmoid(2.f * u); }

struct EpiProj {
    static constexpr bool PERM = true;
    bf16_t* O; int ldc; int n_gelu, sc_lo, sc_hi;
    __device__ __forceinline__ void operator()(const f32x4 (&acc)[2][2][4][2], const pg8::Unit& u, int wr, int wc, int fr, int fq, LAS const unsigned long long* tab) const {
        const int mode = (u.pn < n_gelu) ? 1 : ((u.pn >= sc_lo && u.pn < sc_hi) ? 2 : 0);
        const int row0 = u.pm * 256 + wr * 64 + fr, col0 = u.pn * 256 + wc * 32 + 8 * fq;
#pragma unroll
        for (int ai = 0; ai < 2; ++ai)
#pragma unroll
            for (int m = 0; m < 4; ++m) { bf16_t* rowp = O + (size_t)(row0 + ai * 128 + m * 16) * ldc + col0;
#pragma unroll
                for (int bj = 0; bj < 2; ++bj) { f32x4 v0 = acc[ai][bj][m][0], v1 = acc[ai][bj][m][1];
                    if (mode == 1) {
#pragma unroll
                        for (int i = 0; i < 4; ++i) { v0[i] = fast_gelu_tanh(v0[i]); v1[i] = fast_gelu_tanh(v1[i]); }
                    } else if (mode == 2) { v0 = v0 * C2; v1 = v1 * C2; }
                    pg8::u32x4 w; w.x = pg8::cvt_pk_bf16(v0[0], v0[1]); w.y = pg8::cvt_pk_bf16(v0[2], v0[3]); w.z = pg8::cvt_pk_bf16(v1[0], v1[1]); w.w = pg8::cvt_pk_bf16(v1[2], v1[3]);
                    *(pg8::u32x4*)(rowp + bj * 128) = w; } }
    }
};
struct EpiOut {
    static constexpr bool PERM = true;
    const float* base32; const bf16_t* base16; bf16_t* out; const float* g1;
    __device__ __forceinline__ void operator()(const f32x4 (&acc)[2][2][4][2], const pg8::Unit& u, int wr, int wc, int fr, int fq, LAS const unsigned long long* tab) const {
        const int col0 = u.pn * 256 + wc * 32 + 8 * fq; const int b = (u.pm * 256) / SEQ;
        f32x4 gv[2][2];
#pragma unroll
        for (int bj = 0; bj < 2; ++bj)
#pragma unroll
            for (int n = 0; n < 2; ++n) gv[bj][n] = *(const f32x4*)(g1 + b * 6144 + col0 + bj * 128 + n * 4);
#pragma unroll
        for (int ai = 0; ai < 2; ++ai)
#pragma unroll
            for (int m = 0; m < 4; ++m) { const size_t off = (size_t)(u.pm * 256 + ai * 128 + wr * 64 + m * 16 + fr) * DM + col0;
#pragma unroll
                for (int bj = 0; bj < 2; ++bj) {
                    f32x4 b0, b1;
                    if (base32) { b0 = *(const f32x4*)(base32 + off + bj * 128); b1 = *(const f32x4*)(base32 + off + bj * 128 + 4); }
                    else { const pg8::u32x4 r = *(const pg8::u32x4*)(base16 + off + bj * 128);
                        b0 = (f32x4){__uint_as_float(r.x << 16), __uint_as_float(r.x & 0xffff0000u), __uint_as_float(r.y << 16), __uint_as_float(r.y & 0xffff0000u)};
                        b1 = (f32x4){__uint_as_float(r.z << 16), __uint_as_float(r.z & 0xffff0000u), __uint_as_float(r.w << 16), __uint_as_float(r.w & 0xffff0000u)}; }
                    const f32x4 v0 = b0 + gv[bj][0] * acc[ai][bj][m][0], v1 = b1 + gv[bj][1] * acc[ai][bj][m][1];
                    pg8::u32x4 w; w.x = pg8::cvt_pk_bf16(v0[0], v0[1]); w.y = pg8::cvt_pk_bf16(v0[2], v0[3]); w.z = pg8::cvt_pk_bf16(v1[0], v1[1]); w.w = pg8::cvt_pk_bf16(v1[2], v1[3]);
                    *(pg8::u32x4*)(out + off + bj * 128) = w; } }
    }
};
struct EpiGU {
    static constexpr bool PERM = true;
    bf16_t* ACT; const int* list; const float* gates;
    __device__ __forceinline__ void operator()(const f32x4 (&acc)[2][2][4][2], const pg8::Unit& u, int wr, int wc, int fr, int fq, LAS const unsigned long long* tab) const {
        unsigned long long rec[2][4];
#pragma unroll
        for (int ai = 0; ai < 2; ++ai)
#pragma unroll
            for (int m = 0; m < 4; ++m) rec[ai][m] = tab[ai * 128 + wr * 64 + m * 16 + fr];
#pragma unroll
        for (int ai = 0; ai < 2; ++ai)
#pragma unroll
            for (int m = 0; m < 4; ++m) { const int rr = u.pm * 256 + ai * 128 + wr * 64 + m * 16 + fr;
                if (rr < u.cnt) {
                    const int ent = (int)(unsigned)rec[ai][m]; const float gt = __uint_as_float((unsigned)(rec[ai][m] >> 32));
                    float o[8];
#pragma unroll
                    for (int n = 0; n < 2; ++n)
#pragma unroll
                        for (int i = 0; i < 4; ++i) { const float g = acc[ai][0][m][n][i]; o[n * 4 + i] = g * fast_sigmoid(g) * acc[ai][1][m][n][i] * gt; }
                    pg8::u32x4 w; w.x = pg8::cvt_pk_bf16(o[0], o[1]); w.y = pg8::cvt_pk_bf16(o[2], o[3]); w.z = pg8::cvt_pk_bf16(o[4], o[5]); w.w = pg8::cvt_pk_bf16(o[6], o[7]);
                    *(pg8::u32x4*)(ACT + (size_t)ent * EFF + u.pn * 128 + wc * 32 + 8 * fq) = w; } }
    }
};
struct EpiDown {
    static constexpr bool PERM = true;
    bf16_t* YS; const int* list;
    __device__ __forceinline__ void operator()(const f32x4 (&acc)[2][2][4][2], const pg8::Unit& u, int wr, int wc, int fr, int fq, LAS const unsigned long long* tab) const {
        int ents[2][4];
#pragma unroll
        for (int ai = 0; ai < 2; ++ai)
#pragma unroll
            for (int m = 0; m < 4; ++m) ents[ai][m] = (int)(unsigned)tab[ai * 128 + wr * 64 + m * 16 + fr];
#pragma unroll
        for (int ai = 0; ai < 2; ++ai)
#pragma unroll
            for (int m = 0; m < 4; ++m) { const int rr = u.pm * 256 + ai * 128 + wr * 64 + m * 16 + fr;
                if (rr < u.cnt) {
                    bf16_t* rowp = YS + (size_t)ents[ai][m] * DM + u.pn * 256 + wc * 32 + 8 * fq;
#pragma unroll
                    for (int bj = 0; bj < 2; ++bj) { const f32x4 v0 = acc[ai][bj][m][0], v1 = acc[ai][bj][m][1];
                        pg8::u32x4 w; w.x = pg8::cvt_pk_bf16(v0[0], v0[1]); w.y = pg8::cvt_pk_bf16(v0[2], v0[3]); w.z = pg8::cvt_pk_bf16(v1[0], v1[1]); w.w = pg8::cvt_pk_bf16(v1[2], v1[3]);
                        *(pg8::u32x4*)(rowp + bj * 128) = w; } } }
    }
};

struct ConvDesc { const float* W; bf16_t* WT; int K, N, kb, n0, drow0; };
__device__ __forceinline__ void conv_load(const ConvDesc& d, float (&v)[32], int lane) {
    const int k0 = 64 * d.kb;
#pragma unroll
    for (int i = 0; i < 16; ++i) { const int kk = 4 * i + (lane >> 4); const pg8::f32x2 t = *(const pg8::f32x2*)(d.W + (size_t)(k0 + kk) * d.N + d.n0 + 2 * (lane & 15)); v[2 * i] = t.x; v[2 * i + 1] = t.y; }
}
__device__ __forceinline__ void conv_finish(const ConvDesc& d, const float (&v)[32], LAS float* scr, int lane) {
    const int k0 = 64 * d.kb;
#pragma unroll
    for (int i = 0; i < 16; ++i) { const int kk = 4 * i + (lane >> 4); scr[kk * 33 + 2 * (lane & 15)] = v[2 * i]; scr[kk * 33 + 2 * (lane & 15) + 1] = v[2 * i + 1]; }
    LDS_WAIT(); asm volatile("" ::: "memory");
    const int c = lane & 7;
#pragma unroll
    for (int j = 0; j < 4; ++j) { const int n = (lane >> 3) + 8 * j; const LAS float* s = scr + (8 * c) * 33 + n;
        v4u o; o.x = pk2(s[0 * 33], s[1 * 33]); o.y = pk2(s[2 * 33], s[3 * 33]); o.z = pk2(s[4 * 33], s[5 * 33]); o.w = pk2(s[6 * 33], s[7 * 33]);
        *(GAS v4u*)(d.WT + (size_t)(d.drow0 + n) * d.K + k0 + 8 * c) = o; }
    LDS_WAIT(); asm volatile("" ::: "memory");
}
struct Args { const float* in[28]; float* out; unsigned char* ws; int ph_lo, ph_hi, li, pad; };

__device__ __forceinline__ int conv_items_total(int L) { return ((L & 1) ? 16 * 144 : 16 * 80) + 512 + 8192 + 4096; }
__device__ __forceinline__ int conv_b1(int L) { return ((L & 1) ? 16 * 144 : 16 * 80) + 512; }
#ifndef CONV_GU_SPLIT
#define CONV_GU_SPLIT 3072
#endif
__device__ __forceinline__ ConvDesc conv_desc(const Args& a, int L, int it) {
    const int i = L >> 1; const bool ev = (L & 1) == 0;
    const int nb = ev ? 80 : 144, n_in = 16 * nb;
    ConvDesc d;
    if (it < n_in) {
        if (ev) { d.W = a.in[6] + (size_t)i * DM * EVEN_IN; d.WT = (bf16_t*)(a.ws + WS_WT_EV_IN) + (size_t)i * EVEN_IN * DM; d.N = EVEN_IN; }
        else { d.W = a.in[17] + (size_t)i * DM * ODD_IN; d.WT = (bf16_t*)(a.ws + WS_WT_OD_IN) + (size_t)i * ODD_IN * DM; d.N = ODD_IN; }
        d.K = DM; d.kb = it / nb; d.n0 = (it % nb) * 32; d.drow0 = d.n0; return d;
    }
    it -= n_in;
    if (it < 512) { d.W = (ev ? a.in[7] : a.in[18]) + (size_t)i * DM * DM; d.WT = (bf16_t*)(a.ws + (ev ? WS_WT_EV_OUT : WS_WT_OD_OUT)) + (size_t)i * DM * DM; d.K = DM; d.N = DM; d.kb = it / 32; d.n0 = (it % 32) * 32; d.drow0 = d.n0; return d; }
    it -= 512;
    if (it < 8192) { const int mi = L * NEXP + (it >> 9), r = it & 511, n0 = (r % 32) * 32, j = n0 & 511;
        d.W = a.in[25] + (size_t)mi * DM * 1024; d.WT = (bf16_t*)(a.ws + WS_WT_GU) + (size_t)mi * 1024 * DM; d.K = DM; d.N = 1024; d.kb = r / 32; d.n0 = n0;
        d.drow0 = (j >> 7) * 256 + (n0 >= 512 ? 128 : 0) + (j & 127); return d; }
    it -= 8192;
    { const int mi = L * NEXP + (it >> 8), r = it & 255; d.W = a.in[26] + (size_t)mi * EFF * DM; d.WT = (bf16_t*)(a.ws + WS_WT_DN) + (size_t)mi * DM * EFF; d.K = EFF; d.N = DM; d.kb = r / 32; d.n0 = (r % 32) * 32; d.drow0 = d.n0; return d; }
}
__device__ __forceinline__ void conv_run(const Args& a, int L, int first, int stride, int end, LAS float* scr, int lane) {
    for (int it = first; it < end; it += 4 * stride) {
        const bool h1 = it + stride < end, h2 = it + 2 * stride < end, h3 = it + 3 * stride < end;
        const ConvDesc d0 = conv_desc(a, L, it);
        const ConvDesc d1 = conv_desc(a, L, h1 ? it + stride : it);
        const ConvDesc d2 = conv_desc(a, L, h2 ? it + 2 * stride : it);
        const ConvDesc d3 = conv_desc(a, L, h3 ? it + 3 * stride : it);
        float v0[32], v1[32], v2[32], v3[32];
        conv_load(d0, v0, lane);
        if (h1) conv_load(d1, v1, lane);
        if (h2) conv_load(d2, v2, lane);
        if (h3) conv_load(d3, v3, lane);
        asm volatile("" ::: "memory"); __builtin_amdgcn_sched_barrier(0);
        conv_finish(d0, v0, scr, lane);
        if (h1) conv_finish(d1, v1, scr, lane);
        if (h2) conv_finish(d2, v2, scr, lane);
        if (h3) conv_finish(d3, v3, scr, lane);
    }
}
__device__ __forceinline__ void filler_convert(const Args& a, LAS unsigned char* lds, int L, int lo, int hi, bool part, int rank, int npart, int wave) {
#ifdef NO_FILLER
    return;
#endif
    if (!part) return;
    const int lane = hw_lane();
    LAS float* scr = (LAS float*)(lds + RING_OFF + wave * 16384);
    conv_run(a, L, lo + rank * NWAVES + wave, npart * NWAVES, hi, scr, lane);
    __syncthreads();
}
__device__ __forceinline__ void p0_prologue(const Args& a, LAS unsigned char* lds, int tid, int lane, int wave, int G) {
    asm volatile("" : "+v"(tid), "+v"(lane));
    if ((int)blockIdx.x < 96) {
        LAS float* cact = (LAS float*)lds;
        LAS float* part = (LAS float*)(lds + 32768);
        const float* c = a.in[1];
        for (int i = tid; i < NB * DM; i += NWAVES * 64) { const float v = c[i]; cact[i] = v / (1.f + __expf(-v)); }
        __syncthreads();
        const int item = blockIdx.x, l = item / 24, n0 = (item % 24) * 256;
        const float* wp = a.in[4] + (size_t)l * DM * 6144 + (size_t)(128 * wave) * 6144 + n0 + lane * 4;
        f32x4 acc[NB];
#pragma unroll
        for (int b = 0; b < NB; ++b) acc[b] = (f32x4){0.f, 0.f, 0.f, 0.f};
#pragma unroll 8
        for (int k = 0; k < 128; ++k) {
            const f32x4 wv = *(const f32x4*)(wp + (size_t)k * 6144);
#pragma unroll
            for (int b = 0; b < NB; ++b) acc[b] += cact[b * DM + 128 * wave + k] * wv;
        }
#pragma unroll
        for (int b = 0; b < NB; ++b) *(LAS f32x4*)(part + (wave * NB + b) * 256 + lane * 4) = acc[b];
        __syncthreads();
        const int idx = tid * 4, b = idx / 256, col = idx % 256;
        f32x4 s = *(const f32x4*)(a.in[5] + l * 6144 + n0 + col);
#pragma unroll
        for (int w = 0; w < NWAVES; ++w) s += *(LAS f32x4*)(part + (w * NB + b) * 256 + col);
        *(f32x4*)((float*)(a.ws + WS_MOD) + ((size_t)l * NB + b) * 6144 + n0 + col) = s;
        __syncthreads();
    }
    for (int e = blockIdx.x * NWAVES * 64 + tid; e < 2 * 4 * 128 * 128; e += G * NWAVES * 64) { const int tt = (e >> 7) & 127, ss = e & 127; ((bf16_t*)(a.ws + WS_SGUW))[e] = (ss <= tt) ? f2bf(a.in[10][e]) : (bf16_t)0; }
    for (int e = blockIdx.x * NWAVES * 64 + tid; e < 16 * DM; e += G * NWAVES * 64) { const int ee = e >> 10, k = e & 1023; const float w = a.in[23][k * 16 + ee]; const bf16_t hi = f2bf(w);
        ((bf16_t*)(a.ws + WS_WRT))[e] = hi; ((bf16_t*)(a.ws + WS_WRT))[16 * DM + e] = f2bf(w - bf2f(hi)); }
    LAS float* scr = (LAS float*)(lds + RING_OFF + wave * 16384);
    const int gw = blockIdx.x * NWAVES + wave, NGW = G * NWAVES;
#ifndef NO_FILLER
    conv_run(a, 0, gw, NGW, conv_b1(0) + CONV_GU_SPLIT, scr, lane);
#else
    for (int L = 0; L < DEPTH; ++L) conv_run(a, L, gw, NGW, conv_items_total(L), scr, lane);
#endif
    __syncthreads();
}

template <int MODE>
__device__ __forceinline__ void phase_norm1(const float* xin, const bf16_t* Xs, bf16_t* Xo, const bf16_t* YS, const float* g2prev, const float* ng, const float* sc, const float* sh, bf16_t* XN, float* out, int lane, int gw, int NGW) {
    asm volatile("" : "+v"(lane), "+s"(gw));
    for (int row = gw; row < T; row += NGW) {
        const int b = row / SEQ;
        f32x4 v[4]; float ss = 0.f;
#pragma unroll
        for (int j = 0; j < 4; ++j) {
            const int col = j * 256 + lane * 4;
            if (MODE == 0) v[j] = *(const f32x4*)(xin + (size_t)row * DM + col);
            else { const uint2 xr = *(const uint2*)(Xs + (size_t)row * DM + col);
                v[j] = (f32x4){__uint_as_float(xr.x << 16), __uint_as_float(xr.x & 0xffff0000u), __uint_as_float(xr.y << 16), __uint_as_float(xr.y & 0xffff0000u)}; }
            if (MODE >= 1) {
                const f32x4 g = *(const f32x4*)(g2prev + b * 6144 + col);
                const uint2 y0 = *(const uint2*)(YS + (size_t)(2 * row) * DM + col), y1 = *(const uint2*)(YS + (size_t)(2 * row + 1) * DM + col);
                v[j][0] += g[0] * (__uint_as_float(y0.x << 16) + __uint_as_float(y1.x << 16));
                v[j][1] += g[1] * (__uint_as_float(y0.x & 0xffff0000u) + __uint_as_float(y1.x & 0xffff0000u));
                v[j][2] += g[2] * (__uint_as_float(y0.y << 16) + __uint_as_float(y1.y << 16));
                v[j][3] += g[3] * (__uint_as_float(y0.y & 0xffff0000u) + __uint_as_float(y1.y & 0xffff0000u));
            }
            if (MODE == 1) { uint2 o; o.x = pk2(v[j][0], v[j][1]); o.y = pk2(v[j][2], v[j][3]); *(uint2*)(Xo + (size_t)row * DM + col) = o; }
            ss += v[j][0] * v[j][0] + v[j][1] * v[j][1] + v[j][2] * v[j][2] + v[j][3] * v[j][3];
        }
        const float r = rsqrtf(wave_sum(ss) * (1.f / DM) + 1e-6f);
#pragma unroll
        for (int j = 0; j < 4; ++j) {
            const int col = j * 256 + lane * 4;
            const f32x4 g = *(const f32x4*)(ng + col);
            if (MODE == 2) { *(f32x4*)(out + (size_t)row * DM + col) = v[j] * r * g; }
            else {
                const f32x4 s1 = *(const f32x4*)(sc + b * 6144 + col), s0 = *(const f32x4*)(sh + b * 6144 + col);
                const f32x4 h = v[j] * r * g * (1.f + s1) + s0;
                uint2 o; o.x = pk2(h[0], h[1]); o.y = pk2(h[2], h[3]);
                *(uint2*)(XN + (size_t)row * DM + col) = o;
            }
        }
    }
}

constexpr int RT_HP = 2064;
constexpr int RT_WT = 0, RT_COEF = 32 * RT_HP, RT_SS = RT_COEF + 8192, RT_PL = RT_SS + 512, RT_LOG = RT_PL + 8192, RT_CNT = RT_LOG + 64 * 17 * 4 + 256;
typedef short bf16x8r __attribute__((ext_vector_type(8)));
typedef unsigned u32x2r __attribute__((ext_vector_type(2)));
__device__ __forceinline__ void phase_router(LAS unsigned char* lds, const bf16_t* X, const float* ng, const float* sc, const float* sh, const bf16_t* wrt, const float* rb, bf16_t* XN, int* cnt, int* list, float* gates, int wave) {
    const int lane = hw_lane(), tid = wave * 64 + lane;
    LAS int* lcnt = (LAS int*)(lds + RT_CNT); LAS int* lbase = lcnt + 16; LAS int* llist = lcnt + 64; LAS float* lgate = (LAS float*)(llist + 16 * 128);
    LAS float* LOG = (LAS float*)(lds + RT_LOG);
    LAS float* gco = (LAS float*)(lds + RT_COEF); LAS float* sho = gco + DM;
    LAS float* SS = (LAS float*)(lds + RT_SS); LAS float* PL = (LAS float*)(lds + RT_PL);
    const int fr = lane & 15, kg = lane >> 4, rt = wave & 3, kh = wave >> 2;
    for (int c = tid; c < 32 * 128; c += NWAVES * 64) { const int row = c >> 7, ch = c & 127; *(LAS pg8::u32x4*)(lds + RT_WT + row * RT_HP + ch * 16) = *(const pg8::u32x4*)(wrt + (size_t)row * DM + ch * 8); }
    for (int rb0 = blockIdx.x * 64; rb0 < T; rb0 += gridDim.x * 64) {
        const int b = rb0 / SEQ;
        if (tid < 16) lcnt[tid] = 0;
        for (int k = tid; k < DM; k += NWAVES * 64) { gco[k] = ng[k] * (1.f + sc[b * 6144 + k]); sho[k] = sh[b * 6144 + k]; }
        asm volatile("" ::: "memory"); __builtin_amdgcn_sched_barrier(0);
        const int row = rb0 + 16 * rt + fr;
        const bf16_t* xr = X + (size_t)row * DM + 512 * kh + 8 * kg;
        float ssq = 0.f;
        {   pg8::u32x4 xq[16];
#pragma unroll
            for (int s4 = 0; s4 < 16; ++s4) xq[s4] = *(const pg8::u32x4*)(xr + 32 * s4);
#pragma unroll
            for (int s4 = 0; s4 < 16; ++s4)
#pragma unroll
                for (int q = 0; q < 4; ++q) { const float a0 = __uint_as_float(xq[s4][q] << 16), a1 = __uint_as_float(xq[s4][q] & 0xffff0000u); ssq += a0 * a0 + a1 * a1; }
        }
        ssq += __shfl_xor(ssq, 16); ssq += __shfl_xor(ssq, 32);
        if (kg == 0) SS[(rt * 2 + kh) * 16 + fr] = ssq;
        __syncthreads();
        const float r = rsqrtf((SS[(rt * 2 + 0) * 16 + fr] + SS[(rt * 2 + 1) * 16 + fr]) * (1.f / DM) + 1e-6f);
        f32x4 acc = (f32x4){0.f, 0.f, 0.f, 0.f};
        bf16_t* xo = XN + (size_t)row * DM + 512 * kh + 8 * kg;
#pragma unroll 1
        for (int hb = 0; hb < 2; ++hb) {
            pg8::u32x4 xp[8];
#pragma unroll
            for (int s8 = 0; s8 < 8; ++s8) xp[s8] = *(const pg8::u32x4*)(xr + 32 * (8 * hb + s8));
#pragma unroll
            for (int s8 = 0; s8 < 8; ++s8) {
                const int k0 = 512 * kh + 32 * (8 * hb + s8) + 8 * kg;
                const f32x4 g0 = *(LAS const f32x4*)(gco + k0), g1 = *(LAS const f32x4*)(gco + k0 + 4), h0 = *(LAS const f32x4*)(sho + k0), h1 = *(LAS const f32x4*)(sho + k0 + 4);
                float hv[8];
#pragma unroll
                for (int q = 0; q < 4; ++q) { const float a0 = __uint_as_float(xp[s8][q] << 16), a1 = __uint_as_float(xp[s8][q] & 0xffff0000u);
                    const float c0 = q < 2 ? g0[2 * q] : g1[2 * q - 4], c1 = q < 2 ? g0[2 * q + 1] : g1[2 * q - 3], d0 = q < 2 ? h0[2 * q] : h1[2 * q - 4], d1 = q < 2 ? h0[2 * q + 1] : h1[2 * q - 3];
                    hv[2 * q] = a0 * r * c0 + d0; hv[2 * q + 1] = a1 * r * c1 + d1; }
                pg8::u32x4 hi, lo;
#pragma unroll
                for (int q = 0; q < 4; ++q) { hi[q] = pk2(hv[2 * q], hv[2 * q + 1]);
                    lo[q] = pk2(hv[2 * q] - __uint_as_float(hi[q] << 16), hv[2 * q + 1] - __uint_as_float(hi[q] & 0xffff0000u)); }
                *(pg8::u32x4*)(xo + 32 * (8 * hb + s8)) = hi;
                const bf16x8r Ah = __builtin_bit_cast(bf16x8r, hi), Al = __builtin_bit_cast(bf16x8r, lo);
                const bf16x8r Bh = *(LAS const bf16x8r*)(lds + RT_WT + fr * RT_HP + k0 * 2), Bl = *(LAS const bf16x8r*)(lds + RT_WT + (16 + fr) * RT_HP + k0 * 2);
                acc = __builtin_amdgcn_mfma_f32_16x16x32_bf16(Ah, Bh, acc, 0, 0, 0);
                acc = __builtin_amdgcn_mfma_f32_16x16x32_bf16(Ah, Bl, acc, 0, 0, 0);
                acc = __builtin_amdgcn_mfma_f32_16x16x32_bf16(Al, Bh, acc, 0, 0, 0);
            }
        }
#pragma unroll
        for (int i = 0; i < 4; ++i) PL[((rt * 2 + kh) * 16 + 4 * kg + i) * 16 + fr] = acc[i];
        __syncthreads();
        for (int v = tid; v < 64 * 16; v += NWAVES * 64) { const int rr = v >> 4, e = v & 15, t4 = rr >> 4, r16 = rr & 15;
            LOG[rr * 17 + e] = PL[((t4 * 2 + 0) * 16 + r16) * 16 + e] + PL[((t4 * 2 + 1) * 16 + r16) * 16 + e]; }
        __syncthreads();
        if (wave == 0) {
            const int row = rb0 + lane;
            float lg[16], mx = -INFINITY;
#pragma unroll
            for (int e = 0; e < 16; ++e) { lg[e] = LOG[lane * 17 + e]; mx = fmaxf(mx, lg[e]); }
            float sum = 0.f;
#pragma unroll
            for (int e = 0; e < 16; ++e) { lg[e] = __expf(lg[e] - mx); sum += lg[e]; }
            const float inv = 1.f / sum;
            float sel[16];
#pragma unroll
            for (int e = 0; e < 16; ++e) { lg[e] *= inv; sel[e] = lg[e] + rb[e]; }
            int grp = 0; float best = -INFINITY;
#pragma unroll
            for (int g = 0; g < 4; ++g) {
                float m1 = -INFINITY, m2 = -INFINITY;
#pragma unroll
                for (int i = 0; i < 4; ++i) { const float sv = sel[4 * g + i]; if (sv > m1) { m2 = m1; m1 = sv; } else if (sv > m2) m2 = sv; }
                const float gs = m1 + m2;
                if (gs > best) { best = gs; grp = g; }
            }
            float s4[4], p4[4];
#pragma unroll
            for (int i = 0; i < 4; ++i) { s4[i] = 0.f; p4[i] = 0.f; }
#pragma unroll
            for (int g = 0; g < 4; ++g)
#pragma unroll
                for (int i = 0; i < 4; ++i) if (g == grp) { s4[i] = sel[4 * g + i]; p4[i] = lg[4 * g + i]; }
            int i1 = 0; float b1 = s4[0];
#pragma unroll
            for (int i = 1; i < 4; ++i) if (s4[i] > b1) { b1 = s4[i]; i1 = i; }
            int i2 = -1; float b2 = -INFINITY;
#pragma unroll
            for (int i = 0; i < 4; ++i) if (i != i1 && s4[i] > b2) { b2 = s4[i]; i2 = i; }
            float pa = 0.f, pb = 0.f;
#pragma unroll
            for (int i = 0; i < 4; ++i) { if (i == i1) pa = p4[i]; if (i == i2) pb = p4[i]; }
            const int e1 = grp * 4 + i1, e2 = grp * 4 + i2;
            const float gi = 1.f / (pa + pb);
            const int p1 = __hip_atomic_fetch_add(lcnt + e1, 1, __ATOMIC_RELAXED, __HIP_MEMORY_SCOPE_WORKGROUP), p2 = __hip_atomic_fetch_add(lcnt + e2, 1, __ATOMIC_RELAXED, __HIP_MEMORY_SCOPE_WORKGROUP);
            llist[e1 * 128 + p1] = row * 2; llist[e2 * 128 + p2] = row * 2 + 1;
            lgate[e1 * 128 + p1] = pa * gi; lgate[e2 * 128 + p2] = pb * gi;
        }
        __syncthreads();
        if (tid < 16) lbase[tid] = atomicAdd(cnt + tid * CNT_STRIDE, lcnt[tid]);
        __syncthreads();
        for (int idx = tid; idx < 16 * 128; idx += NWAVES * 64) { const int e = idx >> 7, pos = idx & 127; if (pos < lcnt[e]) *(int2*)(list + 2 * (e * CAP + lbase[e] + pos)) = make_int2(llist[idx], __float_as_int(lgate[idx])); }
        __syncthreads();
    }
    __syncthreads();
}

typedef short bf16x8v __attribute__((ext_vector_type(8)));
typedef short s16x4 __attribute__((ext_vector_type(4)));
typedef float f32x16 __attribute__((ext_vector_type(16)));
#define MFMA32(a, b, c) __builtin_amdgcn_mfma_f32_32x32x16_bf16(a, b, c, 0, 0, 0)
__device__ __forceinline__ s16x4 lds_tr4(LAS const unsigned char* p) { return __builtin_bit_cast(s16x4, __builtin_amdgcn_ds_read_tr16_b64_v4i16((LAS s16x4*)p)); }
__device__ __forceinline__ bf16x8v cat8(s16x4 a, s16x4 b) { return (bf16x8v){a[0], a[1], a[2], a[3], b[0], b[1], b[2], b[3]}; }
__device__ __forceinline__ float max3f(float a, float b, float c) { float r; asm("v_max3_f32 %0, %1, %2, %3" : "=v"(r) : "v"(a), "v"(b), "v"(c)); return r; }
typedef float f32x2p __attribute__((ext_vector_type(2)));
__device__ __forceinline__ float xhalf_max(float v) { return fmaxf(v, __shfl_xor(v, 32)); }
__device__ __forceinline__ float xhalf_sum(float v) { return v + __shfl_xor(v, 32); }
__device__ __forceinline__ bf16x8v pack8(float a0, float a1, float a2, float a3, float a4, float a5, float a6, float a7) {
    pg8::u32x4 w; w.x = pg8::cvt_pk_bf16(a0, a1); w.y = pg8::cvt_pk_bf16(a2, a3); w.z = pg8::cvt_pk_bf16(a4, a5); w.w = pg8::cvt_pk_bf16(a6, a7);
    return __builtin_bit_cast(bf16x8v, w);
}

constexpr int DA_KPITCH = 144, DA_VPITCH = 320;
constexpr int DA_KBUF = 64 * DA_KPITCH, DA_VBUF = 64 * DA_VPITCH;
constexpr int DA_K_OFF = 0, DA_V_OFF = 4 * DA_KBUF, DA_END = DA_V_OFF + 2 * DA_VBUF;
constexpr int DA_XPITCH = 528;
static_assert(128 * DA_XPITCH <= DA_END, "exchange overlays the K/V buffers");

__device__ __forceinline__ void diff_attn_unit(LAS unsigned char* lds, const bf16_t* PROJ, bf16_t* MIX, int b, int h, int qblk, float lam, float lam_init, const float* subg, int tid, int lane, int wave) {
    const int m = wave >> 2, qs = wave & 3, ql = lane & 31, hi = lane >> 5;
    const int q0 = qblk * 128 + qs * 32, qpos = q0 + ql;
    const size_t rowb = (size_t)b * SEQ;
    const float slope2 = exp2f(-2.f * (float)(h + 1)) * 1.4426950408889634f;
    bf16x8v Qf[4];
#pragma unroll
    for (int s = 0; s < 4; ++s) Qf[s] = *(const bf16x8v*)(PROJ + (rowb + qpos) * EVEN_IN + 1024 + h * 128 + m * 64 + 16 * s + 8 * hi);
    float tab[16];
#pragma unroll
    for (int r = 0; r < 16; ++r) tab[r] = slope2 * (float)((r & 3) + 8 * (r >> 2));
    f32x16 O[4];
#pragma unroll
    for (int d = 0; d < 4; ++d)
#pragma unroll
        for (int r = 0; r < 16; ++r) O[d][r] = 0.f;
    float m_run = -INFINITY, l_run = 0.f;
    const int krow = tid >> 3, kch = tid & 7, vrow = tid >> 4, vch = tid & 15;
    const bf16_t* gk0 = PROJ + (rowb + krow) * EVEN_IN + 1536 + h * 128 + kch * 8;
    const bf16_t* gv0 = PROJ + (rowb + vrow) * EVEN_IN + 2048 + h * 128 + vch * 8;
    const int lk = krow * DA_KPITCH + kch * 16, lv = vrow * DA_VPITCH + vch * 16;
    const int ntiles = 2 * qblk + 2;
    pg8::u32x4 st[4];
#define DA_LOAD(kt) do { const size_t ro = (size_t)(kt) * 64 * EVEN_IN; st[0] = *(const pg8::u32x4*)(gk0 + ro); st[1] = *(const pg8::u32x4*)(gk0 + ro + 64); \
        st[2] = *(const pg8::u32x4*)(gv0 + ro); st[3] = *(const pg8::u32x4*)(gv0 + ro + (size_t)32 * EVEN_IN); } while (0)
#define DA_STORE(buf) do { *(LAS pg8::u32x4*)(lds + DA_K_OFF + ((buf) * 2 + 0) * DA_KBUF + lk) = st[0]; *(LAS pg8::u32x4*)(lds + DA_K_OFF + ((buf) * 2 + 1) * DA_KBUF + lk) = st[1]; \
        *(LAS pg8::u32x4*)(lds + DA_V_OFF + (buf) * DA_VBUF + lv) = st[2]; *(LAS pg8::u32x4*)(lds + DA_V_OFF + (buf) * DA_VBUF + lv + 32 * DA_VPITCH) = st[3]; } while (0)
    DA_LOAD(0); DA_STORE(0);
    __syncthreads();
    const int kbase = ql * DA_KPITCH + hi * 16;
    const int idx = lane & 15, tq = idx >> 2, tp = idx & 3, g16 = (lane >> 4) & 1;
    const int vbase = (4 * hi + tq) * DA_VPITCH + (16 * g16 + 4 * tp) * 2;
    for (int kt = 0; kt < ntiles; ++kt) {
        const int buf = kt & 1;
        if (kt + 1 < ntiles) DA_LOAD(kt + 1);
        if (64 * kt <= q0 + 31) {
            LAS const unsigned char* kp = lds + DA_K_OFF + (buf * 2 + m) * DA_KBUF + kbase;
            LAS const unsigned char* vp = lds + DA_V_OFF + buf * DA_VBUF + vbase;
            f32x16 S0, S1;
            const float base0 = slope2 * (float)(64 * kt + 4 * hi - qpos), base1 = base0 + slope2 * 32.f;
#pragma unroll
            for (int r = 0; r < 16; ++r) { S0[r] = base0 + tab[r]; S1[r] = base1 + tab[r]; }
#pragma unroll
            for (int s = 0; s < 4; ++s) {
                const bf16x8v a0 = *(LAS const bf16x8v*)(kp + 32 * s), a1 = *(LAS const bf16x8v*)(kp + 32 * s + 32 * DA_KPITCH);
                S0 = MFMA32(a0, Qf[s], S0); S1 = MFMA32(a1, Qf[s], S1);
            }
            if (64 * kt + 63 > q0) {
                const int kb = 64 * kt + 4 * hi;
#pragma unroll
                for (int r = 0; r < 16; ++r) { const int key = kb + (r & 3) + 8 * (r >> 2); if (key > qpos) S0[r] = -INFINITY; if (key + 32 > qpos) S1[r] = -INFINITY; }
            }
            float mxa = max3f(S0[0], S0[1], S1[0]), mxb = max3f(S0[2], S0[3], S1[1]);
            mxa = max3f(mxa, S1[2], S1[3]);
#pragma unroll
            for (int r = 4; r < 16; r += 4) { mxa = max3f(mxa, S0[r], S0[r + 1]); mxb = max3f(mxb, S0[r + 2], S0[r + 3]); mxa = max3f(mxa, S1[r], S1[r + 1]); mxb = max3f(mxb, S1[r + 2], S1[r + 3]); }
            const float mx = xhalf_max(fmaxf(mxa, mxb));
            const float m_new = fmaxf(m_run, mx), alpha = __builtin_amdgcn_exp2f(m_run - m_new);
            m_run = m_new;
            f32x2p ps2 = (f32x2p){0.f, 0.f};
#pragma unroll
            for (int r = 0; r < 16; r += 2) {
                S0[r] = __builtin_amdgcn_exp2f(S0[r] - m_new); S0[r + 1] = __builtin_amdgcn_exp2f(S0[r + 1] - m_new); S1[r] = __builtin_amdgcn_exp2f(S1[r] - m_new); S1[r + 1] = __builtin_amdgcn_exp2f(S1[r + 1] - m_new);
                ps2 += (f32x2p){S0[r], S0[r + 1]}; ps2 += (f32x2p){S1[r], S1[r + 1]};
            }
            const float ps = ps2.x + ps2.y;
            l_run = l_run * alpha + ps;
#pragma unroll
            for (int d = 0; d < 4; ++d)
#pragma unroll
                for (int r = 0; r < 16; ++r) O[d][r] *= alpha;
            bf16x8v Pb[4];
            Pb[0] = pack8(S0[0], S0[1], S0[2], S0[3], S0[4], S0[5], S0[6], S0[7]);
            Pb[1] = pack8(S0[8], S0[9], S0[10], S0[11], S0[12], S0[13], S0[14], S0[15]);
            Pb[2] = pack8(S1[0], S1[1], S1[2], S1[3], S1[4], S1[5], S1[6], S1[7]);
            Pb[3] = pack8(S1[8], S1[9], S1[10], S1[11], S1[12], S1[13], S1[14], S1[15]);
#pragma unroll
            for (int kk = 0; kk < 4; ++kk)
#pragma unroll
                for (int d = 0; d < 4; ++d) {
                    const s16x4 lo = lds_tr4(vp + (16 * kk) * DA_VPITCH + d * 64), hi4 = lds_tr4(vp + (16 * kk + 8) * DA_VPITCH + d * 64);
                    O[d] = MFMA32(cat8(lo, hi4), Pb[kk], O[d]);
                }
        }
        if (kt + 1 < ntiles) DA_STORE(buf ^ 1);
        __syncthreads();
    }
#undef DA_LOAD
#undef DA_STORE
    const float inv = 1.f / xhalf_sum(l_run);
    const float sc = (m == 1) ? inv * lam : inv;
    LAS float* xrow = (LAS float*)(lds + (qs * 32 + ql) * DA_XPITCH);
    if (m == 1) {
#pragma unroll
        for (int d = 0; d < 4; ++d)
#pragma unroll
            for (int g = 0; g < 4; ++g) *(LAS f32x4*)(xrow + 32 * d + 8 * g + 4 * hi) = (f32x4){O[d][4 * g] * sc, O[d][4 * g + 1] * sc, O[d][4 * g + 2] * sc, O[d][4 * g + 3] * sc};
    }
    __syncthreads();
    if (m == 0) {
        float ss = 0.f;
#pragma unroll
        for (int d = 0; d < 4; ++d)
#pragma unroll
            for (int g = 0; g < 4; ++g) { const f32x4 o2 = *(LAS const f32x4*)(xrow + 32 * d + 8 * g + 4 * hi);
#pragma unroll
                for (int i = 0; i < 4; ++i) { const float v = O[d][4 * g + i] * sc - o2[i]; O[d][4 * g + i] = v; ss += v * v; } }
        const float rn = rsqrtf(xhalf_sum(ss) * (1.f / 128.f) + 1e-6f) * (1.f - lam_init);
        bf16_t* orow = MIX + (rowb + qpos) * DM + 512 + h * 128;
#pragma unroll
        for (int d = 0; d < 4; ++d)
#pragma unroll
            for (int g = 0; g < 4; ++g) { const int dd = 32 * d + 8 * g + 4 * hi; const f32x4 sg = *(const f32x4*)(subg + dd);
                uint2 w; w.x = pg8::cvt_pk_bf16(O[d][4 * g] * rn * sg[0], O[d][4 * g + 1] * rn * sg[1]); w.y = pg8::cvt_pk_bf16(O[d][4 * g + 2] * rn * sg[2], O[d][4 * g + 3] * rn * sg[3]);
                *(uint2*)(orow + dd) = w; }
    }
    __syncthreads();
}

constexpr int SG_PITCH = 1024;
__device__ __forceinline__ int sg_addr(int row, int colbytes) { return row * SG_PITCH + ((((colbytes >> 6) ^ (row & 3)) << 6) | (colbytes & 63)); }
__device__ __forceinline__ void sgu_unit(LAS unsigned char* lds, const bf16_t* PROJ, bf16_t* MIX, const bf16_t* Wb, const float* bs, const float* lng, const float* lnb, int b, int c, int lane, int wave) {
    const size_t tok0 = (size_t)b * SEQ + c * 128;
    {
        float gw[8], gb[8];
#pragma unroll
        for (int i = 0; i < 8; ++i) { gw[i] = lng[lane * 8 + i]; gb[i] = lnb[lane * 8 + i]; }
        pg8::u32x4 raws[16];
#pragma unroll
        for (int i = 0; i < 16; ++i) raws[i] = *(const pg8::u32x4*)(PROJ + (tok0 + wave * 16 + i) * EVEN_IN + 512 + lane * 8);
#pragma unroll
        for (int i = 0; i < 16; ++i) {
            const int s = wave * 16 + i;
            const pg8::u32x4 raw = raws[i];
            float v[8];
            v[0] = __uint_as_float(raw.x << 16); v[1] = __uint_as_float(raw.x & 0xffff0000u); v[2] = __uint_as_float(raw.y << 16); v[3] = __uint_as_float(raw.y & 0xffff0000u);
            v[4] = __uint_as_float(raw.z << 16); v[5] = __uint_as_float(raw.z & 0xffff0000u); v[6] = __uint_as_float(raw.w << 16); v[7] = __uint_as_float(raw.w & 0xffff0000u);
            float sm = 0.f;
#pragma unroll
            for (int j = 0; j < 8; ++j) sm += v[j];
            const float mean = wave_sum(sm) * (1.f / 512.f);
            float sq = 0.f;
#pragma unroll
            for (int j = 0; j < 8; ++j) { v[j] -= mean; sq += v[j] * v[j]; }
            const float rstd = rsqrtf(wave_sum(sq) * (1.f / 512.f) + 1e-5f);
#pragma unroll
            for (int j = 0; j < 8; ++j) v[j] = v[j] * rstd * gw[j] + gb[j];
            *(LAS bf16x8v*)(lds + sg_addr(s, lane * 16)) = pack8(v[0], v[1], v[2], v[3], v[4], v[5], v[6], v[7]);
        }
    }
    __syncthreads();
    const int g = wave >> 1, th = wave & 1, tl = lane & 31, hi = lane >> 5;
    const int idx = lane & 15, tq = idx >> 2, tp = idx & 3, g16 = (lane >> 4) & 1;
    for (int t2 = 0; t2 < 2; ++t2) {
        const int tt = 2 * th + t2;
        f32x16 acc[4];
#pragma unroll
        for (int d = 0; d < 4; ++d)
#pragma unroll
            for (int r = 0; r < 16; ++r) acc[d][r] = 0.f;
        const bf16_t* wrow = Wb + ((size_t)g * 128 + 32 * tt + tl) * 128 + 8 * hi;
        const int nks = 2 * (tt + 1);
        for (int ks = 0; ks < nks; ++ks) {
            const bf16x8v bw = *(const bf16x8v*)(wrow + 16 * ks);
            const int r0 = 16 * ks + 8 * hi + tq;
#pragma unroll
            for (int d = 0; d < 4; ++d) {
                const int cb = (g * 128 + 32 * d + 16 * g16 + 4 * tp) * 2;
                const s16x4 lo = lds_tr4(lds + sg_addr(r0, cb)), hi4 = lds_tr4(lds + sg_addr(r0 + 4, cb));
                acc[d] = MFMA32(cat8(lo, hi4), bw, acc[d]);
            }
        }
        const int t = 32 * tt + tl; const size_t tok = tok0 + t;
        const float bias = bs[g * 128 + t];
#pragma unroll
        for (int d = 0; d < 4; ++d)
#pragma unroll
            for (int gg = 0; gg < 4; ++gg) { const int ch = g * 128 + 32 * d + 8 * gg + 4 * hi;
                const uint2 ur = *(const uint2*)(PROJ + tok * EVEN_IN + ch);
                const float u0 = __uint_as_float(ur.x << 16), u1 = __uint_as_float(ur.x & 0xffff0000u), u2 = __uint_as_float(ur.y << 16), u3 = __uint_as_float(ur.y & 0xffff0000u);
                uint2 w; w.x = pg8::cvt_pk_bf16(u0 * (acc[d][4 * gg] + bias), u1 * (acc[d][4 * gg + 1] + bias)); w.y = pg8::cvt_pk_bf16(u2 * (acc[d][4 * gg + 2] + bias), u3 * (acc[d][4 * gg + 3] + bias));
                *(uint2*)(MIX + tok * DM + ch) = w; }
    }
    __syncthreads();
}

__device__ __forceinline__ void phase_even_mixer(const Args& a, LAS unsigned char* lds, int l, int tid, int lane, int wave) {
    asm volatile("" : "+v"(tid), "+v"(lane));
    unsigned char* wsp = a.ws;
    const int i = l >> 1, c = blockIdx.x;
    const bf16_t* PROJ = (const bf16_t*)(wsp + WS_PROJ); bf16_t* MIX = (bf16_t*)(wsp + WS_MIX);
    const float lam_init = (l == 0) ? 0.2f : 0.47071301834305654f;
    const float lam = __expf(wave_sum(a.in[12][i * 64 + lane] * a.in[13][i * 64 + lane])) - __expf(wave_sum(a.in[14][i * 64 + lane] * a.in[15][i * 64 + lane])) + lam_init;
    for (int cc = c; cc < 256; cc += gridDim.x) {
        const int bh = cc & 31, j = cc >> 5, b = bh >> 2, h = bh & 3;
        for (int u = 0; u < 2; ++u) diff_attn_unit(lds, PROJ, MIX, b, h, u ? j : 15 - j, lam, lam_init, a.in[16] + i * 128, tid, lane, wave);
    }
    for (int cc = c; cc < 128; cc += gridDim.x)
        sgu_unit(lds, PROJ, MIX, (const bf16_t*)(wsp + WS_SGUW) + (size_t)i * 4 * 128 * 128, a.in[11] + i * 512, a.in[8] + i * 512, a.in[9] + i * 512, cc >> 4, cc & 15, lane, wave);
}
constexpr int DL_VPITCH = 192, DL_VBUF = 32 * DL_VPITCH;
__device__ __forceinline__ void dil_attn_unit(LAS unsigned char* lds, const bf16_t* PROJ, bf16_t* OG, float* LSE, bf16_t* MIX, int b, int h, int blk, int tid, int lane, int wave) {
    const int ql = lane & 31, hi = lane >> 5;
    const int idx = lane & 15, tq = idx >> 2, tp = idx & 3, g16 = (lane >> 4) & 1;
    const size_t rowb = (size_t)b * SEQ;
    const int blk0 = blk * 512;
    const float slope2 = exp2f(-(float)(h + 1)) * 1.4426950408889634f;
    LAS unsigned char* vl = lds + wave * (2 * DL_VBUF);
    const int vrow = lane >> 3, vch = lane & 7;
    const int vbase = (4 * hi + tq) * DL_VPITCH + (16 * g16 + 4 * tp) * 2;
    for (int it = wave; it < 32; it += NWAVES) {
        const int g = it < 16 ? (it >> 3) : 2, j = it < 16 ? (it & 7) : (it - 16);
        const int nh = (g == 2) ? 1 : 2;
        const int dil = (g == 0) ? 1 : (g == 1 ? 4 : 16);
        const int pbase = blk0 + ((g == 0) ? 64 * j : (g == 1 ? (j & 3) + 256 * (j >> 2) : j));
        bf16x8v Qf[2][4];
#pragma unroll
        for (int hh = 0; hh < 2; ++hh) { const int qp = pbase + dil * (32 * (hh < nh ? hh : 0) + ql); const bf16_t* qrow = PROJ + (rowb + qp) * ODD_IN + g * 512 + h * 64 + 8 * hi;
#pragma unroll
            for (int s = 0; s < 4; ++s) Qf[hh][s] = *(const bf16x8v*)(qrow + 16 * s); }
        f32x16 O[2][2];
#pragma unroll
        for (int hh = 0; hh < 2; ++hh)
#pragma unroll
            for (int d = 0; d < 2; ++d)
#pragma unroll
                for (int r = 0; r < 16; ++r) O[hh][d][r] = 0.f;
        float m_run[2] = {-INFINITY, -INFINITY}, l_run[2] = {0.f, 0.f};
        int c0 = -4;
        while (pbase + dil * 32 * c0 < 0) ++c0;
        const int clast = nh - 1;
        const bf16_t* kcol = PROJ + 1536 + g * 512 + h * 64 + 8 * hi;
        const bf16_t* vcol = PROJ + 3072 + h * 64 + vch * 8;
        bf16x8v kc[4], kn[4]; pg8::u32x4 vn[4];
#define DL_LOADK(dst, c) do { const bf16_t* kr = kcol + (rowb + pbase + dil * (32 * (c) + ql)) * ODD_IN; _Pragma("unroll") for (int s = 0; s < 4; ++s) dst[s] = *(const bf16x8v*)(kr + 16 * s); } while (0)
#define DL_LOADV(c) do { _Pragma("unroll") for (int n = 0; n < 4; ++n) vn[n] = *(const pg8::u32x4*)(vcol + (rowb + pbase + dil * (32 * (c) + vrow + 8 * n)) * ODD_IN); } while (0)
#define DL_STOREV(buf) do { _Pragma("unroll") for (int n = 0; n < 4; ++n) *(LAS pg8::u32x4*)(vl + (buf) * DL_VBUF + (vrow + 8 * n) * DL_VPITCH + vch * 16) = vn[n]; } while (0)
        DL_LOADK(kc, c0); DL_LOADV(c0); DL_STOREV(c0 & 1);
        for (int c = c0; c <= clast; ++c) {
            if (c < clast) { DL_LOADK(kn, c + 1); DL_LOADV(c + 1); }
            LAS const unsigned char* vp = vl + (c & 1) * DL_VBUF + vbase;
#pragma unroll
            for (int hh = 0; hh < 2; ++hh) {
                const int ch = c - hh;
                if (hh < nh && ch >= -4 && ch <= 0) {
                    f32x16 S;
                    const float base = slope2 * (float)(32 * ch + 4 * hi - ql);
#pragma unroll
                    for (int r = 0; r < 16; ++r) S[r] = fmaf(slope2, (float)((r & 3) + 8 * (r >> 2)), base);
#pragma unroll
                    for (int s = 0; s < 4; ++s) S = MFMA32(kc[s], Qf[hh][s], S);
                    if (ch == -4) {
#pragma unroll
                        for (int r = 0; r < 16; ++r) { const int kk = 4 * hi + (r & 3) + 8 * (r >> 2); if (kk < ql) S[r] = -INFINITY; }
                    }
                    if (ch == 0) {
#pragma unroll
                        for (int r = 0; r < 16; ++r) { const int kk = 4 * hi + (r & 3) + 8 * (r >> 2); if (kk > ql) S[r] = -INFINITY; }
                    }
                    float mx = S[0];
#pragma unroll
                    for (int r = 1; r < 16; ++r) mx = fmaxf(mx, S[r]);
                    mx = xhalf_max(mx);
                    const float m_new = fmaxf(m_run[hh], mx), alpha = __builtin_amdgcn_exp2f(m_run[hh] - m_new);
                    m_run[hh] = m_new;
                    float ps = 0.f;
#pragma unroll
                    for (int r = 0; r < 16; ++r) { S[r] = __builtin_amdgcn_exp2f(S[r] - m_new); ps += S[r]; }
                    l_run[hh] = l_run[hh] * alpha + ps;
#pragma unroll
                    for (int d = 0; d < 2; ++d)
#pragma unroll
                        for (int r = 0; r < 16; ++r) O[hh][d][r] *= alpha;
                    bf16x8v Pb[2];
                    Pb[0] = pack8(S[0], S[1], S[2], S[3], S[4], S[5], S[6], S[7]);
                    Pb[1] = pack8(S[8], S[9], S[10], S[11], S[12], S[13], S[14], S[15]);
#pragma unroll
                    for (int ks = 0; ks < 2; ++ks)
#pragma unroll
                        for (int d = 0; d < 2; ++d) {
                            const s16x4 lo = lds_tr4(vp + (16 * ks) * DL_VPITCH + d * 64), hi4 = lds_tr4(vp + (16 * ks + 8) * DL_VPITCH + d * 64);
                            O[hh][d] = MFMA32(cat8(lo, hi4), Pb[ks], O[hh][d]);
                        }
                }
            }
            if (c < clast) {
                DL_STOREV((c + 1) & 1);
#pragma unroll
                for (int s = 0; s < 4; ++s) kc[s] = kn[s];
            }
        }
#undef DL_LOADK
#undef DL_LOADV
#undef DL_STOREV
#pragma unroll
        for (int hh = 0; hh < 2; ++hh) {
            if (hh < nh) {
                const int qp = pbase + dil * (32 * hh + ql);
                const float lt = xhalf_sum(l_run[hh]), inv = 1.f / lt;
                bf16_t* orow = OG + ((size_t)g * T + rowb + qp) * 512 + h * 64;
#pragma unroll
                for (int d = 0; d < 2; ++d)
#pragma unroll
                    for (int gg = 0; gg < 4; ++gg) { uint2 w; w.x = pg8::cvt_pk_bf16(O[hh][d][4 * gg] * inv, O[hh][d][4 * gg + 1] * inv); w.y = pg8::cvt_pk_bf16(O[hh][d][4 * gg + 2] * inv, O[hh][d][4 * gg + 3] * inv);
                        *(uint2*)(orow + 32 * d + 8 * gg + 4 * hi) = w; }
                if (hi == 0) LSE[((size_t)g * T + rowb + qp) * 8 + h] = m_run[hh] + __log2f(lt);
            }
        }
    }
    VM_WAIT();
    __syncthreads();
#pragma unroll
    for (int k8 = 0; k8 < 8; ++k8) { const int id = tid + k8 * (NWAVES * 64);
        const int p = id >> 3, ch = id & 7; const size_t tok = rowb + blk0 + p;
        float ls[3], mxl = -INFINITY;
#pragma unroll
        for (int g = 0; g < 3; ++g) { ls[g] = LSE[((size_t)g * T + tok) * 8 + h]; mxl = fmaxf(mxl, ls[g]); }
        float wsum = 0.f;
#pragma unroll
        for (int g = 0; g < 3; ++g) { ls[g] = __builtin_amdgcn_exp2f(ls[g] - mxl); wsum += ls[g]; }
        const float wi = 1.f / wsum;
        float o[8];
#pragma unroll
        for (int i = 0; i < 8; ++i) o[i] = 0.f;
#pragma unroll
        for (int g = 0; g < 3; ++g) {
            const pg8::u32x4 raw = *(const pg8::u32x4*)(OG + ((size_t)g * T + tok) * 512 + h * 64 + ch * 8);
            const float wg = ls[g] * wi;
            o[0] += wg * __uint_as_float(raw.x << 16); o[1] += wg * __uint_as_float(raw.x & 0xffff0000u); o[2] += wg * __uint_as_float(raw.y << 16); o[3] += wg * __uint_as_float(raw.y & 0xffff0000u);
            o[4] += wg * __uint_as_float(raw.z << 16); o[5] += wg * __uint_as_float(raw.z & 0xffff0000u); o[6] += wg * __uint_as_float(raw.w << 16); o[7] += wg * __uint_as_float(raw.w & 0xffff0000u);
        }
        *(bf16x8v*)(MIX + tok * DM + h * 64 + ch * 8) = pack8(o[0], o[1], o[2], o[3], o[4], o[5], o[6], o[7]);
    }
    __syncthreads();
}

constexpr int CV_ROWS = 94, CV_PITCH = 1024, CV_RED_OFF = 98304;
__device__ __forceinline__ void conv_unit(LAS unsigned char* lds, const bf16_t* PROJ, bf16_t* MIX, const float* cw, const float* cb, const float* lg, const float* lb, int tile, int tid, int lane, int wave) {
    asm volatile("" : "+v"(tid), "+v"(lane));
    const int t0 = tile * 64, s0 = t0 % SEQ;
    {
#pragma unroll
        for (int k = 0; k < 12; ++k) {
            const int id = tid + k * (NWAVES * 64), r = id >> 6, ch = id & 63;
            if (r < CV_ROWS) {
                pg8::u32x4 w = (pg8::u32x4){0u, 0u, 0u, 0u};
                if (s0 - 30 + r >= 0) {
                    const bf16_t* p = PROJ + (size_t)(t0 - 30 + r) * ODD_IN + 3584 + 8 * ch;
                    const pg8::u32x4 av = *(const pg8::u32x4*)p, gv = *(const pg8::u32x4*)(p + 512);
#pragma unroll
                    for (int q = 0; q < 4; ++q) { const float a0 = __uint_as_float(av[q] << 16), a1 = __uint_as_float(av[q] & 0xffff0000u), g0 = __uint_as_float(gv[q] << 16), g1 = __uint_as_float(gv[q] & 0xffff0000u);
                        w[q] = pg8::cvt_pk_bf16(a0 * fast_sigmoid(g0), a1 * fast_sigmoid(g1)); }
                }
                *(LAS pg8::u32x4*)(lds + r * CV_PITCH + ch * 16) = w;
            }
        }
    }
    const int c = tid;
    float w[31];
#pragma unroll
    for (int k = 0; k < 31; ++k) w[k] = cw[k * 512 + c];
    const float bias = cb[c];
    __syncthreads();
    float o[64];
#pragma unroll
    for (int tg = 0; tg < 16; ++tg) {
        float x[34];
#pragma unroll
        for (int r = 0; r < 34; ++r) x[r] = __uint_as_float((unsigned)(*(LAS const unsigned short*)(lds + (4 * tg + r) * CV_PITCH + c * 2)) << 16);
#pragma unroll
        for (int jj = 0; jj < 4; ++jj) {
            float a = bias;
#pragma unroll
            for (int k = 0; k < 31; ++k) a += w[k] * x[jj + k];
            o[4 * tg + jj] = a;
        }
    }
    int rbo = CV_RED_OFF; asm volatile("" : "+v"(rbo));
    LAS float* red = (LAS float*)(lds + rbo);
#pragma unroll
    for (int rd = 0; rd < 2; ++rd) {
        float v[64];
#pragma unroll
        for (int t = 0; t < 32; ++t) { v[2 * t] = o[32 * rd + t]; v[2 * t + 1] = o[32 * rd + t] * o[32 * rd + t]; }
#pragma unroll
        for (int n = 32; n >= 1; n >>= 1) {
            const bool up = (lane & n) != 0;
#pragma unroll
            for (int k = 0; k < n; ++k) { const float keep = up ? v[k + n] : v[k], send = up ? v[k] : v[k + n]; v[k] = keep + __shfl_xor(send, n); }
        }
        red[(wave * 2 + rd) * 64 + lane] = v[0];
    }
    __syncthreads();
    if (tid < 64) {
        float sm = 0.f, sq = 0.f;
#pragma unroll
        for (int wv = 0; wv < 8; ++wv) { sm += red[(wv * 2 + (tid >> 5)) * 64 + 2 * (tid & 31)]; sq += red[(wv * 2 + (tid >> 5)) * 64 + 2 * (tid & 31) + 1]; }
        const float mean = sm * (1.f / 512.f), var = sq * (1.f / 512.f) - mean * mean;
        red[1024 + 2 * tid] = mean; red[1024 + 2 * tid + 1] = rsqrtf(fmaxf(var, 0.f) + 1e-5f);
    }
    __syncthreads();
    const float gq = lg[c], bq = lb[c];
#pragma unroll
    for (int t = 0; t < 64; ++t) {
        const float mean = red[1024 + 2 * t], rstd = red[1024 + 2 * t + 1];
        const float y = (o[t] - mean) * rstd * gq + bq;
        *(LAS unsigned short*)(lds + t * CV_PITCH + c * 2) = f2bf(y * fast_sigmoid(y));
    }
    __syncthreads();
#pragma unroll
    for (int k8 = 0; k8 < 8; ++k8) { const int id = tid + k8 * (NWAVES * 64); const int t = id >> 6, ch = id & 63;
        *(pg8::u32x4*)(MIX + (size_t)(t0 + t) * DM + 512 + ch * 8) = *(LAS const pg8::u32x4*)(lds + t * CV_PITCH + ch * 16); }
    __syncthreads();
}

#ifndef RP_DIL
#define RP_DIL 1
#endif
#ifndef RP_CONV
#define RP_CONV 1
#endif
#ifndef REPEAT
#define REPEAT(n) _Pragma("unroll 1") for (int rep_ = 0; rep_ < (n); ++rep_)
#endif
__device__ __forceinline__ void phase_odd_mixer(const Args& a, LAS unsigned char* lds, int l, int tid, int lane, int wave) {
    asm volatile("" : "+v"(tid), "+v"(lane));
    unsigned char* wsp = a.ws;
    const int i = l >> 1;
    const bf16_t* PROJ = (const bf16_t*)(wsp + WS_PROJ); bf16_t* MIX = (bf16_t*)(wsp + WS_MIX);
    REPEAT(RP_DIL) for (int cc = blockIdx.x; cc < 256; cc += gridDim.x) {
        const int bh = cc & 63, blk = cc >> 6;
        dil_attn_unit(lds, PROJ, (bf16_t*)(wsp + WS_OG), (float*)(wsp + WS_LSE), MIX, bh >> 3, bh & 7, blk, tid, lane, wave);
    }
    REPEAT(RP_CONV) for (int cc = blockIdx.x; cc < 256; cc += gridDim.x)
        conv_unit(lds, PROJ, MIX, a.in[19] + (size_t)i * 31 * 512, a.in[20] + i * 512, a.in[21] + i * 512, a.in[22] + i * 512, cc, tid, lane, wave);
}
#ifndef RP_PRO
#define RP_PRO 1
#endif
#ifndef RP_NORM0
#define RP_NORM0 1
#endif
#ifndef RP_INPROJ
#define RP_INPROJ 1
#endif
#ifndef RP_MIXE
#define RP_MIXE 1
#endif
#ifndef RP_MIXO
#define RP_MIXO 1
#endif
#ifndef RP_OUT0
#define RP_OUT0 1
#endif
#ifndef RP_ROUTER
#define RP_ROUTER 1
#endif
#ifndef RP_GU
#define RP_GU 1
#endif
#ifndef RP_DOWN
#define RP_DOWN 1
#endif
#ifndef RP_COMB
#define RP_COMB 1
#endif
#ifndef RP_BAR
#define RP_BAR 1
#endif
#ifndef REPEAT
#define REPEAT(n) _Pragma("unroll 1") for (int rep_ = 0; rep_ < (n); ++rep_)
#endif
constexpr int N_PHASES = 2 + 7 * DEPTH;

__global__ void __launch_bounds__(NWAVES * 64, 2) mega(Args a) {
    extern __shared__ __attribute__((aligned(16))) unsigned char lds_raw[];
    LAS unsigned char* lds = (LAS unsigned char*)lds_raw;
    volatile LAS unsigned* MISC = (volatile LAS unsigned*)(lds + MISC_OFF);
    const int wave = __builtin_amdgcn_readfirstlane((int)threadIdx.x >> 6), G = gridDim.x;
#define tid (wave * 64 + hw_lane())
#define lane hw_lane()
    const int gw = blockIdx.x * NWAVES + wave, NGW = G * NWAVES;
    unsigned char* ws = a.ws;
    gu32* ctl = (gu32*)(ws + WS_CTL);
    for (int u = tid; u < (LDS_BYTES - LDSCTL_OFF) / 4; u += NWAVES * 64) ((LAS unsigned*)(lds + LDSCTL_OFF))[u] = 0u;
    __syncthreads();
    XcdBarrier bar = xcd_barrier_post((unsigned*)ctl + CW_BAR + a.li * 4096, MISC + 8, wave);
#define IN(k) true
#define SEAM(k) do { if ((k) + 1 < N_PHASES) { REPEAT(RP_BAR) xcd_barrier(bar, wave); } } while (0)

    if (IN(0) || IN(1)) {
    float* MOD = (float*)(ws + WS_MOD); bf16_t* XN = (bf16_t*)(ws + WS_XN);
    if (IN(0)) { REPEAT(RP_PRO) p0_prologue(a, lds, tid, lane, wave, G); SEAM(0); }
    if (IN(1)) { REPEAT(RP_NORM0) phase_norm1<0>(a.in[0], nullptr, nullptr, nullptr, nullptr, a.in[2], MOD + 1 * DM, MOD + 0 * DM, XN, nullptr, lane, gw, NGW); SEAM(1); }
    }
    for (int l = 0; l < DEPTH; ++l) {
        const int pb = 2 + 7 * l, i = l >> 1;
        ctl = (gu32*)(ws + WS_CTL);
        float* MOD = (float*)(ws + WS_MOD); bf16_t* X = (bf16_t*)(ws + WS_X); bf16_t* XB = (bf16_t*)(ws + WS_XB);
        bf16_t* XN = (bf16_t*)(ws + WS_XN); bf16_t* PROJ = (bf16_t*)(ws + WS_PROJ); bf16_t* MIX = (bf16_t*)(ws + WS_MIX);
        bf16_t* ACT = (bf16_t*)(ws + WS_ACT); bf16_t* YS = (bf16_t*)(ws + WS_YS); int* LIST = (int*)(ws + WS_LIST); float* GATE = (float*)(ws + WS_GATE);
        const float* mod = MOD + (size_t)l * NB * 6144;
        int* cnt = (int*)ctl + CW_CNT + l * 16 * CNT_STRIDE;
        if (IN(pb + 0)) {
            const bool ev = (l & 1) == 0;
            pg8::Gemm g{XN, ev ? (const bf16_t*)(ws + WS_WT_EV_IN) + (size_t)i * EVEN_IN * DM : (const bf16_t*)(ws + WS_WT_OD_IN) + (size_t)i * ODD_IN * DM, DM, 0};
            pg8::StaticOrder S; S.init(T, ev ? EVEN_IN : ODD_IN, G, (int)blockIdx.x);
            EpiProj E{PROJ, ev ? EVEN_IN : ODD_IN, (FUSE_PROJ_ACT && ev) ? 4 : 0, FUSE_PROJ_ACT ? (ev ? 4 : 0) : 0, FUSE_PROJ_ACT ? 6 : 0};
            REPEAT(RP_INPROJ) pg8::gemm_phase<EpiProj, pg8::StaticOrder>(lds + RING_OFF, g, S, E, wave);
            { int fr_, fn_; const bool fp_ = S.filler_rank(fr_, fn_); const int b1 = conv_b1(l); filler_convert(a, lds, l, b1 + CONV_GU_SPLIT, b1 + 8192, fp_, fr_, fn_, wave); }
            SEAM(pb + 0);
        }
        if (IN(pb + 1)) {
            if ((l & 1) == 0) { REPEAT(RP_MIXE) phase_even_mixer(a, lds, l, tid, lane, wave); }
            else { REPEAT(RP_MIXO) phase_odd_mixer(a, lds, l, tid, lane, wave); }
            SEAM(pb + 1);
        }
        if (IN(pb + 2)) {
            const bool ev = (l & 1) == 0;
            pg8::Gemm g{MIX, (const bf16_t*)(ws + (ev ? WS_WT_EV_OUT : WS_WT_OD_OUT)) + (size_t)i * DM * DM, DM, 0};
            pg8::StaticOrder S; S.init(T, DM, G, (int)blockIdx.x);
            EpiOut E{l == 0 ? a.in[0] : nullptr, XB, X, mod + 2 * DM};
            REPEAT(RP_OUT0) pg8::gemm_phase<EpiOut, pg8::StaticOrder>(lds + RING_OFF, g, S, E, wave);
            SEAM(pb + 2);
        }
        if (IN(pb + 3)) {
            phase_router(lds, X, a.in[3] + l * DM, mod + 4 * DM, mod + 3 * DM, (const bf16_t*)(ws + WS_WRT), a.in[24], XN, cnt, LIST, GATE, wave);
            REPEAT(RP_ROUTER - 1) phase_router(lds, X, a.in[3] + l * DM, mod + 4 * DM, mod + 3 * DM, (const bf16_t*)(ws + WS_WRT), a.in[24], XN, (int*)ctl + 8192 + l * 16 * CNT_STRIDE, (int*)(ws + WS_OG), (float*)(ws + WS_OG + 2 * MiB), wave);
            SEAM(pb + 3);
        }
        if (IN(pb + 4)) {
            pg8::Gemm g{XN, (const bf16_t*)(ws + WS_WT_GU) + (size_t)l * NEXP * 1024 * DM, DM, (size_t)1024 * DM};
            LAS int* ctab = (LAS int*)(lds + LDSCTL_OFF + 1024);
            { const int t_ = tid; if (t_ < NEXP) ctab[t_] = __hip_atomic_load(cnt + t_ * CNT_STRIDE, RLX_AGENT); } __syncthreads();
            pg8::MoeOrder<1> S{ctab, LIST, 4, G, (int)blockIdx.x};
            EpiGU E{ACT, LIST, GATE};
            REPEAT(RP_GU) pg8::gemm_phase<EpiGU, pg8::MoeOrder<1>>(lds + RING_OFF, g, S, E, wave, (LAS unsigned long long*)(lds + LDSCTL_OFF + 2048));
            { int fr_, fn_; const bool fp_ = S.filler_rank(fr_, fn_); const int b2 = conv_b1(l) + 8192; filler_convert(a, lds, l, b2, b2 + 4096, fp_, fr_, fn_, wave);
              if (l + 1 < DEPTH) filler_convert(a, lds, l + 1, 0, conv_b1(l + 1), fp_, fr_, fn_, wave); }
            SEAM(pb + 4);
        }
        if (IN(pb + 5)) {
            pg8::Gemm g{ACT, (const bf16_t*)(ws + WS_WT_DN) + (size_t)l * NEXP * DM * EFF, EFF, (size_t)DM * EFF};
            LAS int* ctab = (LAS int*)(lds + LDSCTL_OFF + 1024);
            { const int t_ = tid; if (t_ < NEXP) ctab[t_] = __hip_atomic_load(cnt + t_ * CNT_STRIDE, RLX_AGENT); } __syncthreads();
            pg8::MoeOrder<0> S{ctab, LIST, 4, G, (int)blockIdx.x};
            EpiDown E{YS, LIST};
            REPEAT(RP_DOWN) pg8::gemm_phase<EpiDown, pg8::MoeOrder<0>>(lds + RING_OFF, g, S, E, wave, (LAS unsigned long long*)(lds + LDSCTL_OFF + 2048));
            if (l + 1 < DEPTH) { int fr_, fn_; const bool fp_ = S.filler_rank(fr_, fn_); const int b1 = conv_b1(l + 1); filler_convert(a, lds, l + 1, b1, b1 + CONV_GU_SPLIT, fp_, fr_, fn_, wave); }
            SEAM(pb + 5);
        }
        if (IN(pb + 6)) {
            if (l + 1 < DEPTH) REPEAT(RP_COMB) phase_norm1<1>(nullptr, X, XB, YS, mod + 5 * DM, a.in[2] + (l + 1) * DM, mod + NB * 6144 + 1 * DM, mod + NB * 6144 + 0 * DM, XN, nullptr, lane, gw, NGW);
            else REPEAT(RP_COMB) phase_norm1<2>(nullptr, X, nullptr, YS, mod + 5 * DM, a.in[27], nullptr, nullptr, nullptr, a.out, lane, gw, NGW);
            SEAM(pb + 6);
        }
    }
#undef IN
#undef SEAM
#undef tid
#undef lane
}
static void launch_mega(const Args& base, int lo, int hi, int li, int grid, hipStream_t stream) {
    Args a = base; a.ph_lo = lo; a.ph_hi = hi; a.li = li; a.pad = 0;
    hipLaunchKernelGGL(mega, dim3(grid), dim3(NWAVES * 64), LDS_BYTES, stream, a);
}
extern "C" void kernel_launch(void* const* d_in, const int* in_sizes, int n_in, void* d_out, int out_size, void* d_ws, size_t ws_size, hipStream_t stream) {
    static int grid = 0;
    if (grid == 0) {
        if (ws_size < WS_END2 || n_in != 28) { fprintf(stderr, "kernel_launch: workspace too small or wrong inputs: %zu < %zu, n_in %d\n", ws_size, (size_t)WS_END2, n_in); grid = -1; return; }
        int dev = 0, cus = 0;
        if (hipGetDevice(&dev) != hipSuccess || hipDeviceGetAttribute(&cus, hipDeviceAttributeMultiprocessorCount, dev) != hipSuccess) { grid = -1; return; }
        if (hipFuncSetAttribute((const void*)mega, hipFuncAttributeMaxDynamicSharedMemorySize, LDS_BYTES) != hipSuccess) { fprintf(stderr, "kernel_launch: hipFuncSetAttribute failed\n"); grid = -1; return; }
        int per_cu = 0;
        if (hipOccupancyMaxActiveBlocksPerMultiprocessor(&per_cu, (const void*)mega, NWAVES * 64, LDS_BYTES) != hipSuccess || per_cu < 1) fprintf(stderr, "kernel_launch: occupancy query reports %d\n", per_cu);
        (void)hipGetLastError();
        grid = cus;
    }
    if (grid < 0) return;
    const float* sgu_ln_g = (const float*)d_in[8]; const float* sgu_ln_b = (const float*)d_in[9];
    const float* sgu_w = (const float*)d_in[10]; const float* sgu_b = (const float*)d_in[11];
    const float* lam_q1 = (const float*)d_in[12]; const float* lam_k1 = (const float*)d_in[13];
    const float* lam_q2 = (const float*)d_in[14]; const float* lam_k2 = (const float*)d_in[15];
    const float* subln_g = (const float*)d_in[16];
    const float* conv_w = (const float*)d_in[19]; const float* conv_b = (const float*)d_in[20];
    const float* conv_ln_g = (const float*)d_in[21]; const float* conv_ln_b = (const float*)d_in[22];
    unsigned char* ws = (unsigned char*)d_ws;
    bf16_t* PROJ = (bf16_t*)(ws + WS_PROJ); bf16_t* MIX = (bf16_t*)(ws + WS_MIX); bf16_t* VN = (bf16_t*)(ws + WS_VN);

    (void)hipMemsetAsync(ws + WS_CTL, 0, 1 * MiB, stream);
    Args a{};
    for (int i = 0; i < 28; ++i) a.in[i] = (const float*)d_in[i];
    a.out = (float*)d_out; a.ws = ws;
    int li = 0;
    launch_mega(a, 0, N_PHASES, li++, grid, stream);
}
```

```cpp
#include <hip/hip_runtime.h>
#include <stdint.h>
#include <stdio.h>

typedef unsigned short bf16_t;
typedef float f32x4 __attribute__((ext_vector_type(4)));

constexpr int NB = 8, SEQ = 2048, DM = 1024, T = NB * SEQ, DEPTH = 4;
constexpr int EVEN_IN = 2560, ODD_IN = 4608;
constexpr int NEXP = 16, EFF = 512, CAP = 16384;

__device__ __forceinline__ float bf2f(bf16_t v) { return __uint_as_float(((unsigned)v) << 16); }
__device__ __forceinline__ bf16_t f2bf(float f) { unsigned u = __float_as_uint(f); return (bf16_t)((u + 0x7fffu + ((u >> 16) & 1u)) >> 16); }
__device__ __forceinline__ float gelu_tanh(float x) { return 0.5f * x * (1.f + tanhf(0.7978845608028654f * (x + 0.044715f * x * x * x))); }
__device__ __forceinline__ float sigmoidf_(float x) { return 1.f / (1.f + __expf(-x)); }
__device__ __forceinline__ float wave_sum(float v) {
#pragma unroll
    for (int o = 1; o < 64; o <<= 1) v += __shfl_xor(v, o);
    return v;
}
__device__ __forceinline__ float wave_max(float v) {
#pragma unroll
    for (int o = 1; o < 64; o <<= 1) v = fmaxf(v, __shfl_xor(v, o));
    return v;
}
__device__ __forceinline__ float block_sum256(float v, float* red) {
    v = wave_sum(v);
    __syncthreads();
    if ((threadIdx.x & 63) == 0) red[threadIdx.x >> 6] = v;
    __syncthreads();
    return red[0] + red[1] + red[2] + red[3];
}

constexpr size_t MiB = 1u << 20;
constexpr size_t WS_CTL = 0;
constexpr size_t WS_MOD = 1 * MiB;
constexpr size_t WS_X = 2 * MiB;
constexpr size_t WS_XN = WS_X + 64 * MiB;
constexpr size_t WS_PROJ = WS_XN + 32 * MiB;
constexpr size_t WS_MIX = WS_PROJ + 144 * MiB;
constexpr size_t WS_VN = WS_MIX + 32 * MiB;
constexpr size_t WS_ACT = WS_VN + 16 * MiB;
constexpr size_t WS_YS = WS_ACT + 32 * MiB;
constexpr size_t WS_LIST = WS_YS + 64 * MiB;
constexpr size_t WS_GATE = WS_LIST + 1 * MiB;
constexpr size_t WS_END = WS_GATE + 1 * MiB;

__global__ __launch_bounds__(256) void k_mod(const float* __restrict__ c, const float* __restrict__ ada_w, const float* __restrict__ ada_b, float* __restrict__ mod) {
    __shared__ float ca[NB][DM];
    for (int i = threadIdx.x; i < NB * DM; i += 256) { float v = c[i]; ca[i / DM][i % DM] = v * sigmoidf_(v); }
    __syncthreads();
    const int gid = blockIdx.x * 256 + threadIdx.x;
    const int l = gid / 6144, j = gid % 6144;
    const float* w = ada_w + (size_t)l * DM * 6144 + j;
    float acc[NB];
#pragma unroll
    for (int b = 0; b < NB; ++b) acc[b] = 0.f;
    for (int k = 0; k < DM; ++k) {
        const float wv = w[(size_t)k * 6144];
#pragma unroll
        for (int b = 0; b < NB; ++b) acc[b] += ca[b][k] * wv;
    }
    const float bias = ada_b[l * 6144 + j];
#pragma unroll
    for (int b = 0; b < NB; ++b) mod[((size_t)l * NB + b) * 6144 + j] = acc[b] + bias;
}

template <bool FIRST, bool ADDMOE>
__global__ __launch_bounds__(256) void k_norm_mod(const float* __restrict__ xin, float* __restrict__ X, const bf16_t* __restrict__ YS, const float* __restrict__ g2prev,
                                                  const float* __restrict__ ng, const float* __restrict__ sc, const float* __restrict__ sh, bf16_t* __restrict__ XN) {
    const int lane = threadIdx.x & 63, row = blockIdx.x * 4 + (threadIdx.x >> 6), b = row / SEQ;
    f32x4 v[4]; float ss = 0.f;
#pragma unroll
    for (int j = 0; j < 4; ++j) {
        const int col = j * 256 + lane * 4;
        v[j] = *(const f32x4*)((FIRST ? xin : X) + (size_t)row * DM + col);
        if (ADDMOE) {
            const f32x4 g = *(const f32x4*)(g2prev + b * 6144 + col);
            const bf16_t* y0 = YS + (size_t)(2 * row) * DM + col; const bf16_t* y1 = y0 + DM;
#pragma unroll
            for (int i = 0; i < 4; ++i) v[j][i] += g[i] * (bf2f(y0[i]) + bf2f(y1[i]));
        }
        if (FIRST || ADDMOE) *(f32x4*)(X + (size_t)row * DM + col) = v[j];
        ss += v[j][0] * v[j][0] + v[j][1] * v[j][1] + v[j][2] * v[j][2] + v[j][3] * v[j][3];
    }
    const float r = rsqrtf(wave_sum(ss) * (1.f / DM) + 1e-6f);
#pragma unroll
    for (int j = 0; j < 4; ++j) {
        const int col = j * 256 + lane * 4;
        const f32x4 g = *(const f32x4*)(ng + col), s1 = *(const f32x4*)(sc + b * 6144 + col), s0 = *(const f32x4*)(sh + b * 6144 + col);
        bf16_t* o = XN + (size_t)row * DM + col;
#pragma unroll
        for (int i = 0; i < 4; ++i) o[i] = f2bf(v[j][i] * r * g[i] * (1.f + s1[i]) + s0[i]);
    }
}

__global__ __launch_bounds__(256) void k_final(const float* __restrict__ X, const bf16_t* __restrict__ YS, const float* __restrict__ g2prev, const float* __restrict__ fg, float* __restrict__ out) {
    const int lane = threadIdx.x & 63, row = blockIdx.x * 4 + (threadIdx.x >> 6), b = row / SEQ;
    f32x4 v[4]; float ss = 0.f;
#pragma unroll
    for (int j = 0; j < 4; ++j) {
        const int col = j * 256 + lane * 4;
        v[j] = *(const f32x4*)(X + (size_t)row * DM + col);
        const f32x4 g = *(const f32x4*)(g2prev + b * 6144 + col);
        const bf16_t* y0 = YS + (size_t)(2 * row) * DM + col; const bf16_t* y1 = y0 + DM;
#pragma unroll
        for (int i = 0; i < 4; ++i) v[j][i] += g[i] * (bf2f(y0[i]) + bf2f(y1[i]));
        ss += v[j][0] * v[j][0] + v[j][1] * v[j][1] + v[j][2] * v[j][2] + v[j][3] * v[j][3];
    }
    const float r = rsqrtf(wave_sum(ss) * (1.f / DM) + 1e-6f);
#pragma unroll
    for (int j = 0; j < 4; ++j) {
        const int col = j * 256 + lane * 4;
        const f32x4 g = *(const f32x4*)(fg + col);
        f32x4 o;
#pragma unroll
        for (int i = 0; i < 4; ++i) o[i] = v[j][i] * r * g[i];
        *(f32x4*)(out + (size_t)row * DM + col) = o;
    }
}

template <int MODE>
__global__ __launch_bounds__(256) void k_gemm(const bf16_t* __restrict__ A, int lda, const float* __restrict__ Bw, int ldb, int K,
                                              bf16_t* __restrict__ Cb, float* __restrict__ Xf, int ldc, const float* __restrict__ gvec,
                                              const int* __restrict__ list, const int* __restrict__ cnt, const float* __restrict__ gates, size_t bstride) {
    __shared__ float As[16][68];
    __shared__ float Bs[16][64];
    __shared__ float Bs2[16][64];
    __shared__ int rsrc[64];
    const int tid = threadIdx.x, e = blockIdx.z, n0 = blockIdx.x * 64, m0 = blockIdx.y * 64;
    const int count = (MODE >= 2) ? cnt[e] : T;
    if (m0 >= count) return;
    const float* Bp = Bw + ((MODE >= 2) ? (size_t)e * bstride : 0);
    if (tid < 64) { const int r = m0 + tid; int ent = r; if (MODE >= 2) ent = (r < count) ? list[e * CAP + r] : -1; rsrc[tid] = ent; }
    __syncthreads();
    const int ar = tid >> 2, ak = (tid & 3) * 4;
    int aent = rsrc[ar]; int asrc = aent < 0 ? 0 : (MODE == 2 ? (aent >> 1) : aent);
    const bf16_t* ap = A + (size_t)asrc * lda + ak;
    const int bk = tid >> 4, bn = (tid & 15) * 4;
    const int tx = tid & 15, ty = tid >> 4;
    float acc[4][4], acc2[4][4];
#pragma unroll
    for (int i = 0; i < 4; ++i)
#pragma unroll
        for (int j = 0; j < 4; ++j) { acc[i][j] = 0.f; acc2[i][j] = 0.f; }
    for (int k0 = 0; k0 < K; k0 += 16) {
        const uint2 av = *(const uint2*)(ap + k0);
        const f32x4 bv = *(const f32x4*)(Bp + (size_t)(k0 + bk) * ldb + n0 + bn);
        f32x4 bv2 = bv;
        if (MODE == 2) bv2 = *(const f32x4*)(Bp + (size_t)(k0 + bk) * ldb + n0 + bn + EFF);
        __syncthreads();
        As[ak + 0][ar] = __uint_as_float(av.x << 16); As[ak + 1][ar] = __uint_as_float(av.x & 0xffff0000u);
        As[ak + 2][ar] = __uint_as_float(av.y << 16); As[ak + 3][ar] = __uint_as_float(av.y & 0xffff0000u);
        *(f32x4*)&Bs[bk][bn] = bv;
        if (MODE == 2) *(f32x4*)&Bs2[bk][bn] = bv2;
        __syncthreads();
#pragma unroll
        for (int k = 0; k < 16; ++k) {
            const f32x4 a = *(const f32x4*)&As[k][ty * 4];
            const f32x4 b = *(const f32x4*)&Bs[k][tx * 4];
#pragma unroll
            for (int i = 0; i < 4; ++i)
#pragma unroll
                for (int j = 0; j < 4; ++j) acc[i][j] += a[i] * b[j];
            if (MODE == 2) {
                const f32x4 b2 = *(const f32x4*)&Bs2[k][tx * 4];
#pragma unroll
                for (int i = 0; i < 4; ++i)
#pragma unroll
                    for (int j = 0; j < 4; ++j) acc2[i][j] += a[i] * b2[j];
            }
        }
    }
#pragma unroll
    for (int i = 0; i < 4; ++i) {
        const int ent = rsrc[ty * 4 + i];
        if (ent < 0) continue;
        const int col = n0 + tx * 4;
        if (MODE == 0) {
            bf16_t* o = Cb + (size_t)ent * ldc + col;
#pragma unroll
            for (int j = 0; j < 4; ++j) o[j] = f2bf(acc[i][j]);
        } else if (MODE == 1) {
            const int b = ent / SEQ;
            float* o = Xf + (size_t)ent * ldc + col;
#pragma unroll
            for (int j = 0; j < 4; ++j) o[j] += gvec[b * 6144 + col + j] * acc[i][j];
        } else if (MODE == 2) {
            const float gt = gates[ent];
            bf16_t* o = Cb + (size_t)ent * ldc + col;
#pragma unroll
            for (int j = 0; j < 4; ++j) { const float g = acc[i][j]; o[j] = f2bf(g * sigmoidf_(g) * acc2[i][j] * gt); }
        } else {
            bf16_t* o = Cb + (size_t)ent * ldc + col;
#pragma unroll
            for (int j = 0; j < 4; ++j) o[j] = f2bf(acc[i][j]);
        }
    }
}

__global__ __launch_bounds__(256) void k_sgu_pre(const bf16_t* __restrict__ PROJ, const float* __restrict__ lg, const float* __restrict__ lb, bf16_t* __restrict__ VN, int fused) {
    __shared__ float red[4];
    const int tok = blockIdx.x, tid = threadIdx.x;
    float a = bf2f(PROJ[(size_t)tok * EVEN_IN + 512 + tid]), b = bf2f(PROJ[(size_t)tok * EVEN_IN + 768 + tid]);
    if (!fused) { a = gelu_tanh(a); b = gelu_tanh(b); }
    const float mean = block_sum256(a + b, red) * (1.f / 512.f);
    const float da = a - mean, db = b - mean;
    const float var = block_sum256(da * da + db * db, red) * (1.f / 512.f);
    const float r = rsqrtf(var + 1e-5f);
    VN[(size_t)tok * 512 + tid] = f2bf(da * r * lg[tid] + lb[tid]);
    VN[(size_t)tok * 512 + 256 + tid] = f2bf(db * r * lg[256 + tid] + lb[256 + tid]);
}
__global__ __launch_bounds__(256) void k_sgu_mix(const bf16_t* __restrict__ PROJ, const bf16_t* __restrict__ VN, const float* __restrict__ W, const float* __restrict__ bs, bf16_t* __restrict__ MIX, int fused) {
    __shared__ bf16_t vn[128][128];
    const int bc = blockIdx.x, g = blockIdx.y, tid = threadIdx.x;
    const int tok0 = bc * 128;
    for (int i = tid; i < 128 * 128; i += 256) { const int s = i >> 7, d = i & 127; vn[s][d] = VN[(size_t)(tok0 + s) * 512 + g * 128 + d]; }
    __syncthreads();
    const int d = tid & 127, half = tid >> 7;
    for (int t = half; t < 128; t += 2) {
        const float* w = W + ((size_t)g * 128 + t) * 128;
        float acc = 0.f;
        for (int s = 0; s <= t; ++s) acc += w[s] * bf2f(vn[s][d]);
        float u = bf2f(PROJ[(size_t)(tok0 + t) * EVEN_IN + g * 128 + d]); if (!fused) u = gelu_tanh(u);
        MIX[(size_t)(tok0 + t) * DM + g * 128 + d] = f2bf(u * (acc + bs[g * 128 + t]));
    }
}

__global__ __launch_bounds__(128) void k_diff_naive(const bf16_t* __restrict__ PROJ, const float* __restrict__ lq1, const float* __restrict__ lk1, const float* __restrict__ lq2, const float* __restrict__ lk2,
                                                    const float* __restrict__ subg, float lam_init, bf16_t* __restrict__ MIX, int fused) {
    __shared__ float sc[2][2][SEQ];
    const float qsc = fused ? 0.6931471805599453f : 0.125f;
    __shared__ float qs[2][128];
    const int lane = threadIdx.x & 63, w = threadIdx.x >> 6;
    const int idx = blockIdx.x * 2 + w, h = idx & 3, tok = idx >> 2, b = tok / SEQ, qpos = tok % SEQ;
    const float lam = __expf(wave_sum(lq1[lane] * lk1[lane])) - __expf(wave_sum(lq2[lane] * lk2[lane])) + lam_init;
    const float slope = exp2f(-2.f * (float)(h + 1));
    qs[w][lane] = bf2f(PROJ[(size_t)tok * EVEN_IN + 1024 + h * 128 + lane]);
    qs[w][64 + lane] = bf2f(PROJ[(size_t)tok * EVEN_IN + 1024 + h * 128 + 64 + lane]);
    __syncthreads();
    float m0 = -INFINITY, m1 = -INFINITY;
    const int nch = qpos / 64 + 1;
    for (int c = 0; c < nch; ++c) {
        const int key = c * 64 + lane;
        float s0 = -INFINITY, s1 = -INFINITY;
        if (key <= qpos) {
            const bf16_t* kp = PROJ + (size_t)(b * SEQ + key) * EVEN_IN + 1536 + h * 128;
            float a0 = 0.f, a1 = 0.f;
            for (int d = 0; d < 64; ++d) { a0 += qs[w][d] * bf2f(kp[d]); a1 += qs[w][64 + d] * bf2f(kp[64 + d]); }
            const float bias = -slope * (float)(qpos - key);
            s0 = a0 * qsc + bias; s1 = a1 * qsc + bias;
        }
        sc[w][0][key] = s0; sc[w][1][key] = s1;
        m0 = fmaxf(m0, s0); m1 = fmaxf(m1, s1);
    }
    m0 = wave_max(m0); m1 = wave_max(m1);
    float l0 = 0.f, l1 = 0.f;
    for (int c = 0; c < nch; ++c) { const int key = c * 64 + lane; l0 += __expf(sc[w][0][key] - m0); l1 += __expf(sc[w][1][key] - m1); }
    l0 = wave_sum(l0); l1 = wave_sum(l1);
    const float i0 = 1.f / l0, i1 = lam / l1;
    for (int c = 0; c < nch; ++c) { const int key = c * 64 + lane; const float a = __expf(sc[w][0][key] - m0) * i0 - __expf(sc[w][1][key] - m1) * i1; sc[w][0][key] = a; }
    __syncthreads();
    float o0 = 0.f, o1 = 0.f;
    for (int key = 0; key <= qpos; ++key) {
        const float a = sc[w][0][key];
        const unsigned vv = *(const unsigned*)(PROJ + (size_t)(b * SEQ + key) * EVEN_IN + 2048 + h * 128 + 2 * lane);
        o0 += a * __uint_as_float(vv << 16); o1 += a * __uint_as_float(vv & 0xffff0000u);
    }
    const float r = rsqrtf(wave_sum(o0 * o0 + o1 * o1) * (1.f / 128.f) + 1e-6f) * (1.f - lam_init);
    bf16_t* o = MIX + (size_t)tok * DM + 512 + h * 128 + 2 * lane;
    o[0] = f2bf(o0 * r * subg[2 * lane]); o[1] = f2bf(o1 * r * subg[2 * lane + 1]);
}

__global__ __launch_bounds__(256) void k_dil_naive(const bf16_t* __restrict__ PROJ, bf16_t* __restrict__ MIX, int fused) {
    __shared__ float qs[4][3][64];
    const float qsc = fused ? 0.6931471805599453f : 0.125f;
    const int lane = threadIdx.x & 63, w = threadIdx.x >> 6;
    const int idx = blockIdx.x * 4 + w, h = idx & 7, tok = idx >> 3, b = tok / SEQ, t = tok % SEQ;
    const float slope = exp2f(-(float)(h + 1));
#pragma unroll
    for (int g = 0; g < 3; ++g) qs[w][g][lane] = bf2f(PROJ[(size_t)tok * ODD_IN + g * 512 + h * 64 + lane]);
    __syncthreads();
    float p[3][3];
    float mx = -INFINITY;
#pragma unroll
    for (int g = 0; g < 3; ++g) {
        const int dil = (g == 0) ? 1 : (g == 1 ? 4 : 16);
#pragma unroll
        for (int jj = 0; jj < 3; ++jj) {
            const int j = jj * 64 + lane, pos = t - j * dil;
            float s = -INFINITY;
            if (j <= 128 && pos >= 0) {
                const bf16_t* kp = PROJ + (size_t)(b * SEQ + pos) * ODD_IN + 1536 + g * 512 + h * 64;
                float a = 0.f;
                for (int d = 0; d < 64; ++d) a += qs[w][g][d] * bf2f(kp[d]);
                s = a * qsc - slope * (float)j;
            }
            p[g][jj] = s; mx = fmaxf(mx, s);
        }
    }
    mx = wave_max(mx);
    float l = 0.f;
#pragma unroll
    for (int g = 0; g < 3; ++g)
#pragma unroll
        for (int jj = 0; jj < 3; ++jj) { p[g][jj] = __expf(p[g][jj] - mx); l += p[g][jj]; }
    l = wave_sum(l);
    float o = 0.f;
#pragma unroll
    for (int g = 0; g < 3; ++g) {
        const int dil = (g == 0) ? 1 : (g == 1 ? 4 : 16);
#pragma unroll
        for (int jj = 0; jj < 3; ++jj) {
            const int nk = (jj == 2) ? 1 : 64;
            for (int kk = 0; kk < nk; ++kk) {
                const float pk = __shfl(p[g][jj], kk);
                int pos = t - (jj * 64 + kk) * dil; if (pos < 0) pos = 0;
                o += pk * bf2f(PROJ[(size_t)(b * SEQ + pos) * ODD_IN + 3072 + h * 64 + lane]);
            }
        }
    }
    MIX[(size_t)tok * DM + h * 64 + lane] = f2bf(o / l);
}

__global__ __launch_bounds__(256) void k_conv_naive(const bf16_t* __restrict__ PROJ, const float* __restrict__ cw, const float* __restrict__ cb, const float* __restrict__ lg, const float* __restrict__ lb, bf16_t* __restrict__ MIX) {
    __shared__ float red[4];
    const int tok = blockIdx.x, tid = threadIdx.x, t = tok % SEQ;
    float v[2];
#pragma unroll
    for (int i = 0; i < 2; ++i) {
        const int ch = tid + i * 256;
        float acc = cb[ch];
        for (int k = 0; k < 31; ++k) {
            const int tt = t - 30 + k;
            if (tt >= 0) {
                const bf16_t* p = PROJ + (size_t)(tok - 30 + k) * ODD_IN + 3584 + ch;
                acc += cw[k * 512 + ch] * bf2f(p[0]) * sigmoidf_(bf2f(p[512]));
            }
        }
        v[i] = acc;
    }
    const float mean = block_sum256(v[0] + v[1], red) * (1.f / 512.f);
    const float d0 = v[0] - mean, d1 = v[1] - mean;
    const float var = block_sum256(d0 * d0 + d1 * d1, red) * (1.f / 512.f);
    const float r = rsqrtf(var + 1e-5f);
    const float y0 = d0 * r * lg[tid] + lb[tid], y1 = d1 * r * lg[tid + 256] + lb[tid + 256];
    MIX[(size_t)tok * DM + 512 + tid] = f2bf(y0 * sigmoidf_(y0));
    MIX[(size_t)tok * DM + 768 + tid] = f2bf(y1 * sigmoidf_(y1));
}

__global__ __launch_bounds__(256) void k_norm_router(const float* __restrict__ X, const float* __restrict__ ng, const float* __restrict__ sc, const float* __restrict__ sh,
                                                     const float* __restrict__ rw, const float* __restrict__ rb, bf16_t* __restrict__ XN, int* __restrict__ cnt, int* __restrict__ list, float* __restrict__ gates) {
    const int lane = threadIdx.x & 63, row = blockIdx.x * 4 + (threadIdx.x >> 6), b = row / SEQ;
    f32x4 v[4]; float ss = 0.f;
#pragma unroll
    for (int j = 0; j < 4; ++j) {
        const int col = j * 256 + lane * 4;
        v[j] = *(const f32x4*)(X + (size_t)row * DM + col);
        ss += v[j][0] * v[j][0] + v[j][1] * v[j][1] + v[j][2] * v[j][2] + v[j][3] * v[j][3];
    }
    const float r = rsqrtf(wave_sum(ss) * (1.f / DM) + 1e-6f);
    float lg[16];
#pragma unroll
    for (int e = 0; e < 16; ++e) lg[e] = 0.f;
#pragma unroll
    for (int j = 0; j < 4; ++j) {
        const int col = j * 256 + lane * 4;
        const f32x4 g = *(const f32x4*)(ng + col), s1 = *(const f32x4*)(sc + b * 6144 + col), s0 = *(const f32x4*)(sh + b * 6144 + col);
        bf16_t* o = XN + (size_t)row * DM + col;
#pragma unroll
        for (int i = 0; i < 4; ++i) {
            const float hv = v[j][i] * r * g[i] * (1.f + s1[i]) + s0[i];
            o[i] = f2bf(hv);
            const float* wr = rw + (size_t)(col + i) * 16;
#pragma unroll
            for (int q = 0; q < 4; ++q) { const f32x4 wv = *(const f32x4*)(wr + 4 * q); lg[4 * q + 0] += hv * wv[0]; lg[4 * q + 1] += hv * wv[1]; lg[4 * q + 2] += hv * wv[2]; lg[4 * q + 3] += hv * wv[3]; }
        }
    }
    float mx = -INFINITY;
#pragma unroll
    for (int e = 0; e < 16; ++e) { lg[e] = wave_sum(lg[e]); mx = fmaxf(mx, lg[e]); }
    float sum = 0.f;
#pragma unroll
    for (int e = 0; e < 16; ++e) { lg[e] = __expf(lg[e] - mx); sum += lg[e]; }
    const float inv = 1.f / sum;
    float sel[16];
#pragma unroll
    for (int e = 0; e < 16; ++e) { lg[e] *= inv; sel[e] = lg[e] + rb[e]; }
    int grp = 0; float best = -INFINITY;
#pragma unroll
    for (int g = 0; g < 4; ++g) {
        float m1 = -INFINITY, m2 = -INFINITY;
#pragma unroll
        for (int i = 0; i < 4; ++i) { const float s = sel[4 * g + i]; if (s > m1) { m2 = m1; m1 = s; } else if (s > m2) m2 = s; }
        const float gs = m1 + m2;
        if (gs > best) { best = gs; grp = g; }
    }
    float s4[4], p4[4];
#pragma unroll
    for (int i = 0; i < 4; ++i) { s4[i] = 0.f; p4[i] = 0.f; }
#pragma unroll
    for (int g = 0; g < 4; ++g)
#pragma unroll
        for (int i = 0; i < 4; ++i) if (g == grp) { s4[i] = sel[4 * g + i]; p4[i] = lg[4 * g + i]; }
    int i1 = 0; float b1 = s4[0];
#pragma unroll
    for (int i = 1; i < 4; ++i) if (s4[i] > b1) { b1 = s4[i]; i1 = i; }
    int i2 = -1; float b2 = -INFINITY;
#pragma unroll
    for (int i = 0; i < 4; ++i) if (i != i1 && s4[i] > b2) { b2 = s4[i]; i2 = i; }
    float pa = 0.f, pb = 0.f;
#pragma unroll
    for (int i = 0; i < 4; ++i) { if (i == i1) pa = p4[i]; if (i == i2) pb = p4[i]; }
    if (lane == 0) {
        const int e1 = grp * 4 + i1, e2 = grp * 4 + i2;
        const float gi = 1.f / (pa + pb);
        const int p1 = atomicAdd(cnt + e1, 1), p2 = atomicAdd(cnt + e2, 1);
        list[e1 * CAP + p1] = row * 2; list[e2 * CAP + p2] = row * 2 + 1;
        gates[row * 2] = pa * gi; gates[row * 2 + 1] = pb * gi;
    }
}

constexpr int CNT_STRIDE = 64;
__device__ __forceinline__ int hw_lane() { unsigned z = 0u; asm volatile("" : "+v"(z)); return (int)__builtin_amdgcn_mbcnt_hi(~0u, __builtin_amdgcn_mbcnt_lo(~0u, z)); }
namespace pg8 {
#define PG8_LAS __attribute__((address_space(3)))
typedef short bf16x8 __attribute__((ext_vector_type(8)));
typedef unsigned u32x4 __attribute__((ext_vector_type(4)));
typedef float f32x2 __attribute__((ext_vector_type(2)));
constexpr int BM = 256, BK = 64, HALF = 128, HTB = HALF * BK * 2, STAGE_BYTES = 8 * HTB, NXCD = 8, WGM = 2;

__host__ __device__ __forceinline__ int lds_byte(int r, int c) { const int st = (r >> 4) * 2 + (c >> 5), rr = r & 15, cc = c & 31, ob = rr * 64 + cc * 2; return st * 1024 + (ob ^ (((ob >> 9) & 1) << 5)); }
__host__ __device__ __forceinline__ void stage_rc(int b, int& R, int& C) { const int st = b / 1024, sb = b % 1024, swz = sb ^ (((sb >> 9) & 1) << 5); R = (st >> 1) * 16 + swz / 64; C = (st & 1) * 32 + (swz % 64) / 2; }
__host__ __device__ __forceinline__ int perm32(int rho) { const int n = rho >> 4, i = rho & 15; return 8 * (i >> 2) + 4 * n + (i & 3); }

struct Unit { int pm, pn, e, cnt; };
struct Gemm { const bf16_t* A; const bf16_t* Bt; int K; size_t bstride; };

__device__ __forceinline__ unsigned cvt_pk_bf16(float lo, float hi) { unsigned r; asm volatile("v_cvt_pk_bf16_f32 %0, %1, %2" : "=v"(r) : "v"(lo), "v"(hi)); return r; }

struct StaticOrder {
    int nM, nN, nwg, G, c;
    __device__ void init(int M, int N, int G_, int c_) { nM = M / BM; nN = N / BM; nwg = nM * nN; G = G_; c = c_; }
    __device__ __forceinline__ bool next(int i, Unit& u) const {
        const long L = (long)i * G + c; if (L >= nwg) return false;
        int wgid = (int)L; { const int q = nwg / NXCD, r = nwg % NXCD, xcd = wgid % NXCD, off = wgid / NXCD; wgid = (xcd < r ? xcd * (q + 1) : r * (q + 1) + (xcd - r) * q) + off; }
        const int nig = WGM * nN, gid = wgid / nig, fm = gid * WGM, gsz = (nM - fm) < WGM ? (nM - fm) : WGM;
        u.pm = fm + ((wgid % nig) % gsz); u.pn = (wgid % nig) / gsz; u.e = 0; u.cnt = 0; return true;
    }
    __device__ __forceinline__ unsigned arow(const Unit& u, int r) const { return (unsigned)(u.pm * BM + r); }
    static constexpr bool HAS_TAB = false;
    __device__ __forceinline__ unsigned long long record(const Unit&, int) const { return 0ull; }
    __device__ __forceinline__ bool filler_rank(int& rank, int& npart) const { const int rem = nwg % G; if (rem == 0) { rank = c; npart = G; return true; } rank = c - rem; npart = G - rem; return c >= rem; }
};
template <int SHIFT>
struct MoeOrder {
    PG8_LAS const int* cnt; const int* list; int nN, G, c;
    __device__ __forceinline__ int total_units() const { int acc = 0;
#pragma unroll
        for (int j = 0; j < NEXP; ++j) acc += (__builtin_amdgcn_readfirstlane(cnt[j]) + BM - 1) / BM;
        return acc * nN; }
    __device__ __forceinline__ void chunk(int U, int x, int& start, int& n) const { const int q = U / NXCD, rm = U % NXCD; n = q + (x < rm ? 1 : 0); start = x * q + (x < rm ? x : rm); }
    __device__ __forceinline__ int my_units(int U) const { int st, n; chunk(U, c % NXCD, st, n); const int r = c / NXCD, W = G / NXCD; return r < n ? (n - r + W - 1) / W : 0; }
    __device__ __forceinline__ int max_units(int U) const { const int W = G / NXCD, nmax = (U + NXCD - 1) / NXCD; return (nmax + W - 1) / W; }
    __device__ __forceinline__ bool next(int i, Unit& u) const {
        int acc = 0; int cj[NEXP];
#pragma unroll
        for (int j = 0; j < NEXP; ++j) { cj[j] = __builtin_amdgcn_readfirstlane(cnt[j]); acc += (cj[j] + BM - 1) / BM; }
        const int U = acc * nN, W = G / NXCD;
        int st, n; chunk(U, c % NXCD, st, n);
        const int jloc = i * W + c / NXCD;
        if (jloc >= n) return false;
        const int uid = st + jloc, mtg = uid / nN; u.pn = uid % nN;
        int e = 0, base = 0, ce = 0; acc = 0;
#pragma unroll
        for (int j = 0; j < NEXP; ++j) { if (j == e) ce = cj[j]; acc += (cj[j] + BM - 1) / BM; if (mtg >= acc) { e = j + 1; base = acc; } }
        u.e = e; u.pm = mtg - base; u.cnt = ce; return true;
    }
    __device__ __forceinline__ unsigned arow(const Unit& u, int r) const {
        int rr = u.pm * BM + r; rr = rr < u.cnt ? rr : u.cnt - 1;
        const int ent = __hip_atomic_load(list + 2 * (u.e * CAP + rr), __ATOMIC_RELAXED, __HIP_MEMORY_SCOPE_AGENT);
        return (unsigned)(ent >> SHIFT);
    }
    static constexpr bool HAS_TAB = true;
    __device__ __forceinline__ unsigned long long record(const Unit& u, int r) const {
        int rr = u.pm * BM + r; rr = rr < u.cnt ? rr : u.cnt - 1;
        return __hip_atomic_load((const unsigned long long*)list + u.e * CAP + rr, __ATOMIC_RELAXED, __HIP_MEMORY_SCOPE_AGENT); }
    __device__ __forceinline__ bool filler_rank(int& rank, int& npart) const {
        const int U = total_units(), W = G / NXCD, mx = max_units(U);
        int tot = 0, myr = -1;
#pragma unroll
        for (int x = 0; x < NXCD; ++x) { int st, n; chunk(U, x, st, n); const int full = n - W * (mx - 1); const int busy = full > 0 ? full : 0;
            if (x == c % NXCD) { const int r = c / NXCD; if (r >= busy) myr = tot + (r - busy); }
            tot += W - busy; }
        if (tot == 0) { rank = c; npart = G; return true; }
        rank = myr; npart = tot; return myr >= 0;
    }
};
template <class Epi, class Sched>
__device__ __forceinline__ void gemm_phase(PG8_LAS unsigned char* lds, const Gemm g, const Sched& S, const Epi& E, int wv, PG8_LAS unsigned long long* tab = nullptr) {
    int tid_ = wv * 64 + hw_lane(); asm volatile("" : "+v"(tid_));
    const int tid = tid_, wid = __builtin_amdgcn_readfirstlane(tid >> 6), lane = tid & 63, wr = wid >> 2, wc = wid & 3, fr = lane & 15, fq = lane >> 4;
    const int K = g.K, nt = K / BK;
    int Rl[2], Cl[2]; unsigned voffB[2];
#pragma unroll
    for (int i = 0; i < 2; ++i) { int R, C; stage_rc(tid * 16 + i * 8192, R, C); const int Rb = Epi::PERM ? ((R & ~31) + perm32(R & 31)) : R;
        Rl[i] = R; Cl[i] = C; voffB[i] = (unsigned)(Rb * K + C) * 2u; }
    const size_t kstep = (size_t)(BK * 2);
    const size_t hstep = (size_t)HALF * K * 2;
    const size_t tstep = 2 * hstep;
    const unsigned ldsw = (unsigned)wid * 1024u;
    const int aoff = lds_byte(wr * 64 + fr, fq * 8), boff = lds_byte(wc * 32 + fr, fq * 8);
#define PG8_SA(b, h) (((b) * 2 + (h)) * HTB)
#define PG8_SB(b, h) ((4 + (b) * 2 + (h)) * HTB)
#define PG8_STAGE(bufoff, gbase, voff) do { _Pragma("unroll") for (int _i = 0; _i < 2; ++_i) \
        __builtin_amdgcn_global_load_lds((const unsigned*)((const char*)(gbase) + (voff)[_i]), (PG8_LAS unsigned*)(lds + (bufoff) + ldsw + _i * 8192), 16, 0, 0); } while (0)
#define PG8_LDA(dst, b, h) do { _Pragma("unroll") for (int m = 0; m < 4; ++m) _Pragma("unroll") for (int k = 0; k < 2; ++k) dst[m][k] = *(const PG8_LAS bf16x8*)(lds + PG8_SA(b, h) + aoff + m * 2048 + k * 1024); } while (0)
#define PG8_LDB(dst, b, h) do { _Pragma("unroll") for (int n = 0; n < 2; ++n) _Pragma("unroll") for (int k = 0; k < 2; ++k) dst[n][k] = *(const PG8_LAS bf16x8*)(lds + PG8_SB(b, h) + boff + n * 2048 + k * 1024); } while (0)
#define PG8_MMA(ai, bj, At, Bt) do { __builtin_amdgcn_s_setprio(1); _Pragma("unroll") for (int m = 0; m < 4; ++m) _Pragma("unroll") for (int n = 0; n < 2; ++n) _Pragma("unroll") for (int k = 0; k < 2; ++k) \
        acc[ai][bj][m][n] = __builtin_amdgcn_mfma_f32_16x16x32_bf16(Bt[n][k], At[m][k], acc[ai][bj][m][n], 0, 0, 0); __builtin_amdgcn_s_setprio(0); } while (0)
#define PG8_WAIT_V(n) asm volatile("s_waitcnt vmcnt(" #n ")" ::: "memory")
#define PG8_WAIT_L(n) asm volatile("s_waitcnt lgkmcnt(" #n ")" ::: "memory")
#define PG8_BAR __builtin_amdgcn_s_barrier()
#define PG8_SCHED __builtin_amdgcn_sched_barrier(0)
#define PG8_AOFF(dst, u) do { _Pragma("unroll") for (int _h = 0; _h < 2; ++_h) _Pragma("unroll") for (int _i = 0; _i < 2; ++_i) \
        dst[_h][_i] = (S.arow(u, _h * HALF + Rl[_i]) * (unsigned)K + (unsigned)Cl[_i]) * 2u; } while (0)
    Unit cur, nxt; int ui = 0;
    if (!S.next(0, cur)) return;
    f32x4 acc[2][2][4][2];
#pragma unroll
    for (int a = 0; a < 2; ++a)
#pragma unroll
        for (int b = 0; b < 2; ++b)
#pragma unroll
            for (int m = 0; m < 4; ++m)
#pragma unroll
                for (int n = 0; n < 2; ++n) acc[a][b][m][n] = (f32x4){0.f, 0.f, 0.f, 0.f};
    bf16x8 At[4][2], B0[2][2], B1[2][2];
    unsigned oA[2][2], oN[2][2];
    PG8_AOFF(oA, cur);
    if (Sched::HAS_TAB) { if (tid < BM) tab[tid] = S.record(cur, tid); }
    const char* const Ab = (const char*)g.A;
    const char* cB = (const char*)g.Bt + ((size_t)cur.e * g.bstride) * 2 + (size_t)cur.pn * tstep;
    PG8_STAGE(PG8_SB(0, 0), cB, voffB); PG8_STAGE(PG8_SB(0, 1), cB + hstep, voffB); PG8_STAGE(PG8_SA(0, 0), Ab, oA[0]); PG8_STAGE(PG8_SA(0, 1), Ab, oA[1]);
    if (wr == 1) PG8_BAR;
    PG8_WAIT_V(2); PG8_BAR;
    PG8_STAGE(PG8_SB(1, 0), cB + kstep, voffB); PG8_STAGE(PG8_SA(1, 0), Ab + kstep, oA[0]); PG8_STAGE(PG8_SB(1, 1), cB + hstep + kstep, voffB);
    PG8_WAIT_V(6); PG8_BAR;
    for (;;) {
        const bool has_next = S.next(ui + 1, nxt);
        if (has_next) { PG8_AOFF(oN, nxt); if (Sched::HAS_TAB) { if (tid < BM) tab[((ui + 1) % 3) * BM + tid] = S.record(nxt, tid); } }
        else {
#pragma unroll
            for (int h = 0; h < 2; ++h)
#pragma unroll
                for (int i = 0; i < 2; ++i) oN[h][i] = oA[h][i];
        }
        const char* nB = has_next ? (const char*)g.Bt + ((size_t)nxt.e * g.bstride) * 2 + (size_t)nxt.pn * tstep : cB;
        for (int t = 0; t < nt; t += 2) {
            const bool last = (t == nt - 2);
            const char* a1 = Ab + (size_t)(t + 1) * kstep;
            const char* a2 = last ? Ab : Ab + (size_t)(t + 2) * kstep; const char* b2 = last ? nB : cB + (size_t)(t + 2) * kstep;
            const char* a3 = a2 + kstep; const char* b3 = b2 + kstep;
            unsigned o2[2][2];
#pragma unroll
            for (int h = 0; h < 2; ++h)
#pragma unroll
                for (int i = 0; i < 2; ++i) o2[h][i] = last ? oN[h][i] : oA[h][i];
            PG8_LDB(B0, 0, 0); PG8_LDB(B1, 0, 1); PG8_SCHED; PG8_LDA(At, 0, 0); PG8_STAGE(PG8_SA(1, 1), a1, oA[1]);
            PG8_WAIT_V(8); PG8_WAIT_L(0); PG8_BAR; PG8_MMA(0, 0, At, B0); PG8_MMA(0, 1, At, B1); PG8_BAR; PG8_SCHED;
            PG8_LDA(At, 0, 1); PG8_STAGE(PG8_SB(0, 0), b2, voffB); PG8_STAGE(PG8_SB(0, 1), b2 + hstep, voffB); PG8_STAGE(PG8_SA(0, 0), a2, o2[0]);
            PG8_WAIT_V(8); PG8_WAIT_L(0); PG8_BAR; PG8_MMA(1, 0, At, B0); PG8_MMA(1, 1, At, B1); PG8_BAR; PG8_SCHED;
            PG8_LDB(B0, 1, 0); PG8_LDB(B1, 1, 1); PG8_SCHED; PG8_LDA(At, 1, 0); PG8_STAGE(PG8_SA(0, 1), a2, o2[1]);
            PG8_WAIT_V(8); PG8_WAIT_L(0); PG8_BAR; PG8_MMA(0, 0, At, B0); PG8_MMA(0, 1, At, B1); PG8_BAR; PG8_SCHED;
            PG8_LDA(At, 1, 1); PG8_STAGE(PG8_SB(1, 0), b3, voffB); PG8_STAGE(PG8_SB(1, 1), b3 + hstep, voffB); PG8_STAGE(PG8_SA(1, 0), a3, o2[0]);
            PG8_WAIT_V(8); PG8_WAIT_L(0); PG8_BAR; PG8_MMA(1, 0, At, B0); PG8_MMA(1, 1, At, B1); PG8_BAR; PG8_SCHED;
        }
        if (wr == 0) PG8_BAR;
        E(acc, cur, wr, wc, fr, fq, tab + (ui % 3) * BM, !has_next);
        if (!has_next) break;
#pragma unroll
        for (int a = 0; a < 2; ++a)
#pragma unroll
            for (int b = 0; b < 2; ++b)
#pragma unroll
                for (int m = 0; m < 4; ++m)
#pragma unroll
                    for (int n = 0; n < 2; ++n) acc[a][b][m][n] = (f32x4){0.f, 0.f, 0.f, 0.f};
        cur = nxt; cB = nB; ++ui;
#pragma unroll
        for (int h = 0; h < 2; ++h)
#pragma unroll
            for (int i = 0; i < 2; ++i) oA[h][i] = oN[h][i];
        if (wr == 1) PG8_BAR;
    }
    PG8_WAIT_V(0);
    PG8_BAR;
#undef PG8_SA
#undef PG8_SB
#undef PG8_STAGE
#undef PG8_LDA
#undef PG8_LDB
#undef PG8_MMA
#undef PG8_WAIT_V
#undef PG8_WAIT_L
#undef PG8_BAR
#undef PG8_SCHED
#undef PG8_AOFF
}
}
#define GAS __attribute__((address_space(1)))
#define LAS __attribute__((address_space(3)))
typedef unsigned v4u __attribute__((ext_vector_type(4)));
typedef GAS unsigned gu32;
#define RLX_AGENT __ATOMIC_RELAXED, __HIP_MEMORY_SCOPE_AGENT
#define LDS_WAIT() asm volatile("s_waitcnt lgkmcnt(0)" ::: "memory")
#define VM_WAIT() asm volatile("s_waitcnt vmcnt(0)" ::: "memory")
constexpr int NWAVES = 8;
constexpr int RING_OFF = 0, RING_BYTES = 131072;
constexpr int LDSCTL_OFF = RING_BYTES, MISC_OFF = LDSCTL_OFF + 320;
constexpr int LDS_BYTES = 147456;

constexpr size_t WS_WT_EV_IN = WS_END;
constexpr size_t WS_WT_EV_OUT = WS_WT_EV_IN + 10 * MiB;
constexpr size_t WS_WT_OD_IN = WS_WT_EV_OUT + 4 * MiB;
constexpr size_t WS_WT_OD_OUT = WS_WT_OD_IN + 18 * MiB;
constexpr size_t WS_WT_GU = WS_WT_OD_OUT + 4 * MiB;
constexpr size_t WS_WT_DN = WS_WT_GU + 128 * MiB;
constexpr size_t WS_SGUW = WS_WT_DN + 64 * MiB;
constexpr size_t WS_OG = WS_SGUW + 1 * MiB;
constexpr size_t WS_LSE = WS_OG + 48 * MiB;
constexpr size_t WS_XB = WS_LSE + 2 * MiB;
constexpr size_t WS_WRT = WS_XB + 64 * MiB;
constexpr size_t WS_END2 = WS_WRT + 1 * MiB;
constexpr int CW_CNT = 0;
constexpr int CW_BAR = 16384;
constexpr float C2 = 0.125f * 1.4426950408889634f;
constexpr bool FUSE_PROJ_ACT = true;

#define XB_TMO      128
#define XB_XCNT(j)  (256  + 64 * (j))
#define XB_XSUB(j)  (1280 + 64 * (j))
#define XB_XGEN(j)  (2304 + 64 * (j))
#define XB_TOP      3328
#define XB_TOPGEN   3392
#define XCD_BAR_WORDS 3456
#define XB_SPIN_CAP (1u << 18)
__device__ __forceinline__ unsigned xb_ld(unsigned* p)              { return __hip_atomic_load(p, __ATOMIC_RELAXED, __HIP_MEMORY_SCOPE_AGENT); }
__device__ __forceinline__ unsigned xb_add(unsigned* p, unsigned v) { return __hip_atomic_fetch_add(p, v, __ATOMIC_RELAXED, __HIP_MEMORY_SCOPE_AGENT); }
__device__ __forceinline__ unsigned xb_xcc_id() { return (unsigned)__builtin_amdgcn_s_getreg((3 << 11) | 20) & 0xFu; }
#define XB_SPIN(cond, bar) do { unsigned _sp = 0; while (cond) { __builtin_amdgcn_s_sleep(1); \
    if ((++_sp & 255u) == 0u) { if (xb_ld(&(bar)[XB_TMO])) break; if (_sp > XB_SPIN_CAP) { atomicAdd(&(bar)[XB_TMO], 1u); break; } } } } while (0)
struct XcdBarrier { unsigned* bar; unsigned x; volatile LAS unsigned* st; };
__device__ __forceinline__ XcdBarrier xcd_barrier_post(unsigned* bar, volatile LAS unsigned* st, int wv) {
    XcdBarrier b; b.bar = bar; b.x = xb_xcc_id(); b.st = st;
    if (wv == 0 && hw_lane() == 0) (void)xb_add(&bar[XB_XCNT(b.x)], 1u);
    return b;
}
__device__ __forceinline__ void xcd_barrier_complete(unsigned* bar, unsigned x, unsigned& nloc, unsigned& nx) {
    const unsigned G = gridDim.x * gridDim.y * gridDim.z;
    unsigned sum, cnt, mine, sp = 0u;
    for (;;) {
        sum = 0u; cnt = 0u; mine = 0u;
#pragma unroll
        for (unsigned j = 0; j < 16; ++j) { const unsigned c = xb_ld(&bar[XB_XCNT(j)]); sum += c; cnt += (c > 0u) ? 1u : 0u; mine = (j == x) ? c : mine; }
        if (sum == G) break;
        __builtin_amdgcn_s_sleep(1);
        if ((++sp & 255u) == 0u) { if (xb_ld(&bar[XB_TMO])) break; if (sp > XB_SPIN_CAP) { atomicAdd(&bar[XB_TMO], 1u); break; } }
    }
    nloc = mine > 0u ? mine : 1u; nx = cnt > 0u ? cnt : 1u;
}
__device__ __forceinline__ void xcd_barrier(const XcdBarrier& b, int wv) {
    asm volatile("s_waitcnt vmcnt(0)" ::: "memory");
    __syncthreads();
    if (wv == 0 && hw_lane() == 0) {
        unsigned* bar = b.bar;
        __builtin_amdgcn_s_waitcnt(0);
        unsigned nloc = b.st[0], nx = b.st[1];
        if (nloc == 0u) { xcd_barrier_complete(bar, b.x, nloc, nx); b.st[0] = nloc; b.st[1] = nx; }
#ifdef HARD_BAR
        __builtin_amdgcn_fence(__ATOMIC_RELEASE, "agent"); asm volatile("s_waitcnt vmcnt(0)" ::: "memory");
#endif
        const unsigned old = xb_add(&bar[XB_XSUB(b.x)], 1u);
        const unsigned gen = old / nloc;
        if (old + 1u == (gen + 1u) * nloc) {
            __builtin_amdgcn_fence(__ATOMIC_RELEASE, "agent");
            asm volatile("s_waitcnt vmcnt(0)" ::: "memory");
            const unsigned og = xb_add(&bar[XB_TOP], 1u);
            const unsigned tg = og / nx;
            if (og + 1u == (tg + 1u) * nx) xb_add(&bar[XB_TOPGEN], 1u);
            else XB_SPIN(xb_ld(&bar[XB_TOPGEN]) == tg, bar);
            __builtin_amdgcn_fence(__ATOMIC_ACQUIRE, "agent");
            xb_add(&bar[XB_XGEN(b.x)], 1u);
            asm volatile("s_waitcnt vmcnt(0)" ::: "memory");
        } else {
            XB_SPIN(xb_ld(&bar[XB_XGEN(b.x)]) == gen, bar);
            __builtin_amdgcn_fence(__ATOMIC_ACQUIRE, "agent");
            asm volatile("s_waitcnt vmcnt(0)" ::: "memory");
        }
    }
    __syncthreads();
}

__device__ __forceinline__ void st16_epi(void* p, pg8::u32x4 v, bool wt) {
#ifndef PLAIN_STORES
    if (wt) asm volatile("global_store_dwordx4 %0, %1, off sc1\n\ts_nop 1" :: "v"(p), "v"(v) : "memory"); else
#endif
    *(pg8::u32x4*)p = v;
}
__device__ __forceinline__ unsigned pk2(float lo, float hi) { return (unsigned)f2bf(lo) | ((unsigned)f2bf(hi) << 16); }
__device__ __forceinline__ float fast_sigmoid(float x) { return __builtin_amdgcn_rcpf(1.f + __builtin_amdgcn_exp2f(-1.4426950408889634f * x)); }
__device__ __forceinline__ float fast_gelu_tanh(float x) { const float u = 0.7978845608028654f * (x + 0.044715f * x * x * x); return x * fast_sigmoid(2.f * u); }

struct EpiProj {
    static constexpr bool PERM = true;
    bf16_t* O; int ldc; int n_gelu, sc_lo, sc_hi;
    __device__ __forceinline__ void operator()(const f32x4 (&acc)[2][2][4][2], const pg8::Unit& u, int wr, int wc, int fr, int fq, LAS const unsigned long long* tab, bool wt) const {
        const int mode = (u.pn < n_gelu) ? 1 : ((u.pn >= sc_lo && u.pn < sc_hi) ? 2 : 0);
        const int row0 = u.pm * 256 + wr * 64 + fr, col0 = u.pn * 256 + wc * 32 + 8 * fq;
#pragma unroll
        for (int ai = 0; ai < 2; ++ai)
#pragma unroll
            for (int m = 0; m < 4; ++m) { bf16_t* rowp = O + (size_t)(row0 + ai * 128 + m * 16) * ldc + col0;
#pragma unroll
                for (int bj = 0; bj < 2; ++bj) { f32x4 v0 = acc[ai][bj][m][0], v1 = acc[ai][bj][m][1];
                    if (mode == 1) {
#pragma unroll
                        for (int i = 0; i < 4; ++i) { v0[i] = fast_gelu_tanh(v0[i]); v1[i] = fast_gelu_tanh(v1[i]); }
                    } else if (mode == 2) { v0 = v0 * C2; v1 = v1 * C2; }
                    pg8::u32x4 w; w.x = pg8::cvt_pk_bf16(v0[0], v0[1]); w.y = pg8::cvt_pk_bf16(v0[2], v0[3]); w.z = pg8::cvt_pk_bf16(v1[0], v1[1]); w.w = pg8::cvt_pk_bf16(v1[2], v1[3]);
                    st16_epi(rowp + bj * 128, w, wt); } }
    }
};
struct EpiOut {
    static constexpr bool PERM = true;
    const float* base32; const bf16_t* base16; bf16_t* out; const float* g1;
    __device__ __forceinline__ void operator()(const f32x4 (&acc)[2][2][4][2], const pg8::Unit& u, int wr, int wc, int fr, int fq, LAS const unsigned long long* tab, bool wt) const {
        const int col0 = u.pn * 256 + wc * 32 + 8 * fq; const int b = (u.pm * 256) / SEQ;
        f32x4 gv[2][2];
#pragma unroll
        for (int bj = 0; bj < 2; ++bj)
#pragma unroll
            for (int n = 0; n < 2; ++n) gv[bj][n] = *(const f32x4*)(g1 + b * 6144 + col0 + bj * 128 + n * 4);
#pragma unroll
        for (int ai = 0; ai < 2; ++ai)
#pragma unroll
            for (int m = 0; m < 4; ++m) { const size_t off = (size_t)(u.pm * 256 + ai * 128 + wr * 64 + m * 16 + fr) * DM + col0;
#pragma unroll
                for (int bj = 0; bj < 2; ++bj) {
                    f32x4 b0, b1;
                    if (base32) { b0 = *(const f32x4*)(base32 + off + bj * 128); b1 = *(const f32x4*)(base32 + off + bj * 128 + 4); }
                    else { const pg8::u32x4 r = *(const pg8::u32x4*)(base16 + off + bj * 128);
                        b0 = (f32x4){__uint_as_float(r.x << 16), __uint_as_float(r.x & 0xffff0000u), __uint_as_float(r.y << 16), __uint_as_float(r.y & 0xffff0000u)};
                        b1 = (f32x4){__uint_as_float(r.z << 16), __uint_as_float(r.z & 0xffff0000u), __uint_as_float(r.w << 16), __uint_as_float(r.w & 0xffff0000u)}; }
                    const f32x4 v0 = b0 + gv[bj][0] * acc[ai][bj][m][0], v1 = b1 + gv[bj][1] * acc[ai][bj][m][1];
                    pg8::u32x4 w; w.x = pg8::cvt_pk_bf16(v0[0], v0[1]); w.y = pg8::cvt_pk_bf16(v0[2], v0[3]); w.z = pg8::cvt_pk_bf16(v1[0], v1[1]); w.w = pg8::cvt_pk_bf16(v1[2], v1[3]);
                    st16_epi(out + off + bj * 128, w, wt); } }
    }
};
struct EpiGU {
    static constexpr bool PERM = true;
    bf16_t* ACT; const int* list; const float* gates;
    __device__ __forceinline__ void operator()(const f32x4 (&acc)[2][2][4][2], const pg8::Unit& u, int wr, int wc, int fr, int fq, LAS const unsigned long long* tab, bool wt) const {
        unsigned long long rec[2][4];
#pragma unroll
        for (int ai = 0; ai < 2; ++ai)
#pragma unroll
            for (int m = 0; m < 4; ++m) rec[ai][m] = tab[ai * 128 + wr * 64 + m * 16 + fr];
#pragma unroll
        for (int ai = 0; ai < 2; ++ai)
#pragma unroll
            for (int m = 0; m < 4; ++m) { const int rr = u.pm * 256 + ai * 128 + wr * 64 + m * 16 + fr;
                if (rr < u.cnt) {
                    const int ent = (int)(unsigned)rec[ai][m]; const float gt = __uint_as_float((unsigned)(rec[ai][m] >> 32));
                    float o[8];
#pragma unroll
                    for (int n = 0; n < 2; ++n)
#pragma unroll
                        for (int i = 0; i < 4; ++i) { const float g = acc[ai][0][m][n][i]; o[n * 4 + i] = g * fast_sigmoid(g) * acc[ai][1][m][n][i] * gt; }
                    pg8::u32x4 w; w.x = pg8::cvt_pk_bf16(o[0], o[1]); w.y = pg8::cvt_pk_bf16(o[2], o[3]); w.z = pg8::cvt_pk_bf16(o[4], o[5]); w.w = pg8::cvt_pk_bf16(o[6], o[7]);
                    st16_epi(ACT + (size_t)ent * EFF + u.pn * 128 + wc * 32 + 8 * fq, w, wt); } }
    }
};
struct EpiDown {
    static constexpr bool PERM = true;
    bf16_t* YS; const int* list;
    __device__ __forceinline__ void operator()(const f32x4 (&acc)[2][2][4][2], const pg8::Unit& u, int wr, int wc, int fr, int fq, LAS const unsigned long long* tab, bool wt) const {
        int ents[2][4];
#pragma unroll
        for (int ai = 0; ai < 2; ++ai)
#pragma unroll
            for (int m = 0; m < 4; ++m) ents[ai][m] = (int)(unsigned)tab[ai * 128 + wr * 64 + m * 16 + fr];
#pragma unroll
        for (int ai = 0; ai < 2; ++ai)
#pragma unroll
            for (int m = 0; m < 4; ++m) { const int rr = u.pm * 256 + ai * 128 + wr * 64 + m * 16 + fr;
                if (rr < u.cnt) {
                    bf16_t* rowp = YS + (size_t)ents[ai][m] * DM + u.pn * 256 + wc * 32 + 8 * fq;
#pragma unroll
                    for (int bj = 0; bj < 2; ++bj) { const f32x4 v0 = acc[ai][bj][m][0], v1 = acc[ai][bj][m][1];
                        pg8::u32x4 w; w.x = pg8::cvt_pk_bf16(v0[0], v0[1]); w.y = pg8::cvt_pk_bf16(v0[2], v0[3]); w.z = pg8::cvt_pk_bf16(v1[0], v1[1]); w.w = pg8::cvt_pk_bf16(v1[2], v1[3]);
                        st16_epi(rowp + bj * 128, w, wt); } } }
    }
};

struct ConvDesc { const float* W; bf16_t* WT; int K, N, kb, n0, drow0; };
__device__ __forceinline__ void conv_load(const ConvDesc& d, float (&v)[32], int lane) {
    const int k0 = 64 * d.kb;
#pragma unroll
    for (int i = 0; i < 16; ++i) { const int kk = 4 * i + (lane >> 4); const pg8::f32x2 t = *(const pg8::f32x2*)(d.W + (size_t)(k0 + kk) * d.N + d.n0 + 2 * (lane & 15)); v[2 * i] = t.x; v[2 * i + 1] = t.y; }
}
__device__ __forceinline__ void conv_finish(const ConvDesc& d, const float (&v)[32], LAS float* scr, int lane) {
    const int k0 = 64 * d.kb;
#pragma unroll
    for (int i = 0; i < 16; ++i) { const int kk = 4 * i + (lane >> 4); scr[kk * 33 + 2 * (lane & 15)] = v[2 * i]; scr[kk * 33 + 2 * (lane & 15) + 1] = v[2 * i + 1]; }
    LDS_WAIT(); asm volatile("" ::: "memory");
    const int c = lane & 7;
#pragma unroll
    for (int j = 0; j < 4; ++j) { const int n = (lane >> 3) + 8 * j; const LAS float* s = scr + (8 * c) * 33 + n;
        v4u o; o.x = pk2(s[0 * 33], s[1 * 33]); o.y = pk2(s[2 * 33], s[3 * 33]); o.z = pk2(s[4 * 33], s[5 * 33]); o.w = pk2(s[6 * 33], s[7 * 33]);
        *(GAS v4u*)(d.WT + (size_t)(d.drow0 + n) * d.K + k0 + 8 * c) = o; }
    LDS_WAIT(); asm volatile("" ::: "memory");
}
struct Args { const float* in[28]; float* out; unsigned char* ws; int ph_lo, ph_hi, li, pad; };

__device__ __forceinline__ int conv_items_total(int L) { return ((L & 1) ? 16 * 144 : 16 * 80) + 512 + 8192 + 4096; }
__device__ __forceinline__ int conv_b1(int L) { return ((L & 1) ? 16 * 144 : 16 * 80) + 512; }
#ifndef CONV_GU_SPLIT
#define CONV_GU_SPLIT 3072
#endif
__device__ __forceinline__ ConvDesc conv_desc(const Args& a, int L, int it) {
    const int i = L >> 1; const bool ev = (L & 1) == 0;
    const int nb = ev ? 80 : 144, n_in = 16 * nb;
    ConvDesc d;
    if (it < n_in) {
        if (ev) { d.W = a.in[6] + (size_t)i * DM * EVEN_IN; d.WT = (bf16_t*)(a.ws + WS_WT_EV_IN) + (size_t)i * EVEN_IN * DM; d.N = EVEN_IN; }
        else { d.W = a.in[17] + (size_t)i * DM * ODD_IN; d.WT = (bf16_t*)(a.ws + WS_WT_OD_IN) + (size_t)i * ODD_IN * DM; d.N = ODD_IN; }
        d.K = DM; d.kb = it / nb; d.n0 = (it % nb) * 32; d.drow0 = d.n0; return d;
    }
    it -= n_in;
    if (it < 512) { d.W = (ev ? a.in[7] : a.in[18]) + (size_t)i * DM * DM; d.WT = (bf16_t*)(a.ws + (ev ? WS_WT_EV_OUT : WS_WT_OD_OUT)) + (size_t)i * DM * DM; d.K = DM; d.N = DM; d.kb = it / 32; d.n0 = (it % 32) * 32; d.drow0 = d.n0; return d; }
    it -= 512;
    if (it < 8192) { const int mi = L * NEXP + (it >> 9), r = it & 511, n0 = (r % 32) * 32, j = n0 & 511;
        d.W = a.in[25] + (size_t)mi * DM * 1024; d.WT = (bf16_t*)(a.ws + WS_WT_GU) + (size_t)mi * 1024 * DM; d.K = DM; d.N = 1024; d.kb = r / 32; d.n0 = n0;
        d.drow0 = (j >> 7) * 256 + (n0 >= 512 ? 128 : 0) + (j & 127); return d; }
    it -= 8192;
    { const int mi = L * NEXP + (it >> 8), r = it & 255; d.W = a.in[26] + (size_t)mi * EFF * DM; d.WT = (bf16_t*)(a.ws + WS_WT_DN) + (size_t)mi * DM * EFF; d.K = EFF; d.N = DM; d.kb = r / 32; d.n0 = (r % 32) * 32; d.drow0 = d.n0; return d; }
}
__device__ __forceinline__ void conv_run(const Args& a, int L, int first, int stride, int end, LAS float* scr, int lane) {
    for (int it = first; it < end; it += 4 * stride) {
        const bool h1 = it + stride < end, h2 = it + 2 * stride < end, h3 = it + 3 * stride < end;
        const ConvDesc d0 = conv_desc(a, L, it);
        const ConvDesc d1 = conv_desc(a, L, h1 ? it + stride : it);
        const ConvDesc d2 = conv_desc(a, L, h2 ? it + 2 * stride : it);
        const ConvDesc d3 = conv_desc(a, L, h3 ? it + 3 * stride : it);
        float v0[32], v1[32], v2[32], v3[32];
        conv_load(d0, v0, lane);
        if (h1) conv_load(d1, v1, lane);
        if (h2) conv_load(d2, v2, lane);
        if (h3) conv_load(d3, v3, lane);
        asm volatile("" ::: "memory"); __builtin_amdgcn_sched_barrier(0);
        conv_finish(d0, v0, scr, lane);
        if (h1) conv_finish(d1, v1, scr, lane);
        if (h2) conv_finish(d2, v2, scr, lane);
        if (h3) conv_finish(d3, v3, scr, lane);
    }
}
__device__ __forceinline__ void filler_convert(const Args& a, LAS unsigned char* lds, int L, int lo, int hi, bool part, int rank, int npart, int wave) {
#ifdef NO_FILLER
    return;
#endif
    if (!part) return;
    const int lane = hw_lane();
    LAS float* scr = (LAS float*)(lds + RING_OFF + wave * 16384);
    conv_run(a, L, lo + rank * NWAVES + wave, npart * NWAVES, hi, scr, lane);
    __syncthreads();
}
__device__ __forceinline__ void p0_prologue(const Args& a, LAS unsigned char* lds, int tid, int lane, int wave, int G) {
    asm volatile("" : "+v"(tid), "+v"(lane));
    if ((int)blockIdx.x < 96) {
        LAS float* cact = (LAS float*)lds;
        LAS float* part = (LAS float*)(lds + 32768);
        const float* c = a.in[1];
        for (int i = tid; i < NB * DM; i += NWAVES * 64) { const float v = c[i]; cact[i] = v / (1.f + __expf(-v)); }
        __syncthreads();
        const int item = blockIdx.x, l = item / 24, n0 = (item % 24) * 256;
        const float* wp = a.in[4] + (size_t)l * DM * 6144 + (size_t)(128 * wave) * 6144 + n0 + lane * 4;
        f32x4 acc[NB];
#pragma unroll
        for (int b = 0; b < NB; ++b) acc[b] = (f32x4){0.f, 0.f, 0.f, 0.f};
#pragma unroll 8
        for (int k = 0; k < 128; ++k) {
            const f32x4 wv = *(const f32x4*)(wp + (size_t)k * 6144);
#pragma unroll
            for (int b = 0; b < NB; ++b) acc[b] += cact[b * DM + 128 * wave + k] * wv;
        }
#pragma unroll
        for (int b = 0; b < NB; ++b) *(LAS f32x4*)(part + (wave * NB + b) * 256 + lane * 4) = acc[b];
        __syncthreads();
        const int idx = tid * 4, b = idx / 256, col = idx % 256;
        f32x4 s = *(const f32x4*)(a.in[5] + l * 6144 + n0 + col);
#pragma unroll
        for (int w = 0; w < NWAVES; ++w) s += *(LAS f32x4*)(part + (w * NB + b) * 256 + col);
        *(f32x4*)((float*)(a.ws + WS_MOD) + ((size_t)l * NB + b) * 6144 + n0 + col) = s;
        __syncthreads();
    }
    for (int e = blockIdx.x * NWAVES * 64 + tid; e < 2 * 4 * 128 * 128; e += G * NWAVES * 64) { const int tt = (e >> 7) & 127, ss = e & 127; ((bf16_t*)(a.ws + WS_SGUW))[e] = (ss <= tt) ? f2bf(a.in[10][e]) : (bf16_t)0; }
    for (int e = blockIdx.x * NWAVES * 64 + tid; e < 16 * DM; e += G * NWAVES * 64) { const int ee = e >> 10, k = e & 1023; const float w = a.in[23][k * 16 + ee]; const bf16_t hi = f2bf(w);
        ((bf16_t*)(a.ws + WS_WRT))[e] = hi; ((bf16_t*)(a.ws + WS_WRT))[16 * DM + e] = f2bf(w - bf2f(hi)); }
    LAS float* scr = (LAS float*)(lds + RING_OFF + wave * 16384);
    const int gw = blockIdx.x * NWAVES + wave, NGW = G * NWAVES;
#ifndef NO_FILLER
    conv_run(a, 0, gw, NGW, conv_b1(0) + CONV_GU_SPLIT, scr, lane);
#else
    for (int L = 0; L < DEPTH; ++L) conv_run(a, L, gw, NGW, conv_items_total(L), scr, lane);
#endif
    __syncthreads();
}

template <int MODE>
__device__ __forceinline__ void phase_norm1(const float* xin, const bf16_t* Xs, bf16_t* Xo, const bf16_t* YS, const float* g2prev, const float* ng, const float* sc, const float* sh, bf16_t* XN, float* out, int lane, int gw, int NGW) {
    asm volatile("" : "+v"(lane), "+s"(gw));
    for (int row = gw; row < T; row += NGW) {
        const int b = row / SEQ;
        f32x4 v[4]; float ss = 0.f;
#pragma unroll
        for (int j = 0; j < 4; ++j) {
            const int col = j * 256 + lane * 4;
            if (MODE == 0) v[j] = *(const f32x4*)(xin + (size_t)row * DM + col);
            else { const uint2 xr = *(const uint2*)(Xs + (size_t)row * DM + col);
                v[j] = (f32x4){__uint_as_float(xr.x << 16), __uint_as_float(xr.x & 0xffff0000u), __uint_as_float(xr.y << 16), __uint_as_float(xr.y & 0xffff0000u)}; }
            if (MODE >= 1) {
                const f32x4 g = *(const f32x4*)(g2prev + b * 6144 + col);
                const uint2 y0 = *(const uint2*)(YS + (size_t)(2 * row) * DM + col), y1 = *(const uint2*)(YS + (size_t)(2 * row + 1) * DM + col);
                v[j][0] += g[0] * (__uint_as_float(y0.x << 16) + __uint_as_float(y1.x << 16));
                v[j][1] += g[1] * (__uint_as_float(y0.x & 0xffff0000u) + __uint_as_float(y1.x & 0xffff0000u));
                v[j][2] += g[2] * (__uint_as_float(y0.y << 16) + __uint_as_float(y1.y << 16));
                v[j][3] += g[3] * (__uint_as_float(y0.y & 0xffff0000u) + __uint_as_float(y1.y & 0xffff0000u));
            }
            if (MODE == 1) { uint2 o; o.x = pk2(v[j][0], v[j][1]); o.y = pk2(v[j][2], v[j][3]); *(uint2*)(Xo + (size_t)row * DM + col) = o; }
            ss += v[j][0] * v[j][0] + v[j][1] * v[j][1] + v[j][2] * v[j][2] + v[j][3] * v[j][3];
        }
        const float r = rsqrtf(wave_sum(ss) * (1.f / DM) + 1e-6f);
#pragma unroll
        for (int j = 0; j < 4; ++j) {
            const int col = j * 256 + lane * 4;
            const f32x4 g = *(const f32x4*)(ng + col);
            if (MODE == 2) { *(f32x4*)(out + (size_t)row * DM + col) = v[j] * r * g; }
            else {
                const f32x4 s1 = *(const f32x4*)(sc + b * 6144 + col), s0 = *(const f32x4*)(sh + b * 6144 + col);
                const f32x4 h = v[j] * r * g * (1.f + s1) + s0;
                uint2 o; o.x = pk2(h[0], h[1]); o.y = pk2(h[2], h[3]);
                *(uint2*)(XN + (size_t)row * DM + col) = o;
            }
        }
    }
}

constexpr int RT_HP = 2064;
constexpr int RT_WT = 0, RT_COEF = 32 * RT_HP, RT_SS = RT_COEF + 8192, RT_PL = RT_SS + 512, RT_LOG = RT_PL + 8192, RT_CNT = RT_LOG + 64 * 17 * 4 + 256;
typedef short bf16x8r __attribute__((ext_vector_type(8)));
typedef unsigned u32x2r __attribute__((ext_vector_type(2)));
__device__ __forceinline__ void phase_router(LAS unsigned char* lds, const bf16_t* X, const float* ng, const float* sc, const float* sh, const bf16_t* wrt, const float* rb, bf16_t* XN, int* cnt, int* list, float* gates, int wave) {
    const int lane = hw_lane(), tid = wave * 64 + lane;
    LAS int* lcnt = (LAS int*)(lds + RT_CNT); LAS int* lbase = lcnt + 16; LAS int* llist = lcnt + 64; LAS float* lgate = (LAS float*)(llist + 16 * 128);
    LAS float* LOG = (LAS float*)(lds + RT_LOG);
    LAS float* gco = (LAS float*)(lds + RT_COEF); LAS float* sho = gco + DM;
    LAS float* SS = (LAS float*)(lds + RT_SS); LAS float* PL = (LAS float*)(lds + RT_PL);
    const int fr = lane & 15, kg = lane >> 4, rt = wave & 3, kh = wave >> 2;
    for (int c = tid; c < 32 * 128; c += NWAVES * 64) { const int row = c >> 7, ch = c & 127; *(LAS pg8::u32x4*)(lds + RT_WT + row * RT_HP + ch * 16) = *(const pg8::u32x4*)(wrt + (size_t)row * DM + ch * 8); }
    for (int rb0 = blockIdx.x * 64; rb0 < T; rb0 += gridDim.x * 64) {
        const int b = rb0 / SEQ;
        if (tid < 16) lcnt[tid] = 0;
        for (int k = tid; k < DM; k += NWAVES * 64) { gco[k] = ng[k] * (1.f + sc[b * 6144 + k]); sho[k] = sh[b * 6144 + k]; }
        asm volatile("" ::: "memory"); __builtin_amdgcn_sched_barrier(0);
        const int row = rb0 + 16 * rt + fr;
        const bf16_t* xr = X + (size_t)row * DM + 512 * kh + 8 * kg;
        float ssq = 0.f;
        {   pg8::u32x4 xq[16];
#pragma unroll
            for (int s4 = 0; s4 < 16; ++s4) xq[s4] = *(const pg8::u32x4*)(xr + 32 * s4);
#pragma unroll
            for (int s4 = 0; s4 < 16; ++s4)
#pragma unroll
                for (int q = 0; q < 4; ++q) { const float a0 = __uint_as_float(xq[s4][q] << 16), a1 = __uint_as_float(xq[s4][q] & 0xffff0000u); ssq += a0 * a0 + a1 * a1; }
        }
        ssq += __shfl_xor(ssq, 16); ssq += __shfl_xor(ssq, 32);
        if (kg == 0) SS[(rt * 2 + kh) * 16 + fr] = ssq;
        __syncthreads();
        const float r = rsqrtf((SS[(rt * 2 + 0) * 16 + fr] + SS[(rt * 2 + 1) * 16 + fr]) * (1.f / DM) + 1e-6f);
        f32x4 acc = (f32x4){0.f, 0.f, 0.f, 0.f};
        bf16_t* xo = XN + (size_t)row * DM + 512 * kh + 8 * kg;
#pragma unroll 1
        for (int hb = 0; hb < 2; ++hb) {
            pg8::u32x4 xp[8];
#pragma unroll
            for (int s8 = 0; s8 < 8; ++s8) xp[s8] = *(const pg8::u32x4*)(xr + 32 * (8 * hb + s8));
#pragma unroll
            for (int s8 = 0; s8 < 8; ++s8) {
                const int k0 = 512 * kh + 32 * (8 * hb + s8) + 8 * kg;
                const f32x4 g0 = *(LAS const f32x4*)(gco + k0), g1 = *(LAS const f32x4*)(gco + k0 + 4), h0 = *(LAS const f32x4*)(sho + k0), h1 = *(LAS const f32x4*)(sho + k0 + 4);
                float hv[8];
#pragma unroll
                for (int q = 0; q < 4; ++q) { const float a0 = __uint_as_float(xp[s8][q] << 16), a1 = __uint_as_float(xp[s8][q] & 0xffff0000u);
                    const float c0 = q < 2 ? g0[2 * q] : g1[2 * q - 4], c1 = q < 2 ? g0[2 * q + 1] : g1[2 * q - 3], d0 = q < 2 ? h0[2 * q] : h1[2 * q - 4], d1 = q < 2 ? h0[2 * q + 1] : h1[2 * q - 3];
                    hv[2 * q] = a0 * r * c0 + d0; hv[2 * q + 1] = a1 * r * c1 + d1; }
                pg8::u32x4 hi, lo;
#pragma unroll
                for (int q = 0; q < 4; ++q) { hi[q] = pk2(hv[2 * q], hv[2 * q + 1]);
                    lo[q] = pk2(hv[2 * q] - __uint_as_float(hi[q] << 16), hv[2 * q + 1] - __uint_as_float(hi[q] & 0xffff0000u)); }
                *(pg8::u32x4*)(xo + 32 * (8 * hb + s8)) = hi;
                const bf16x8r Ah = __builtin_bit_cast(bf16x8r, hi), Al = __builtin_bit_cast(bf16x8r, lo);
                const bf16x8r Bh = *(LAS const bf16x8r*)(lds + RT_WT + fr * RT_HP + k0 * 2), Bl = *(LAS const bf16x8r*)(lds + RT_WT + (16 + fr) * RT_HP + k0 * 2);
                acc = __builtin_amdgcn_mfma_f32_16x16x32_bf16(Ah, Bh, acc, 0, 0, 0);
                acc = __builtin_amdgcn_mfma_f32_16x16x32_bf16(Ah, Bl, acc, 0, 0, 0);
                acc = __builtin_amdgcn_mfma_f32_16x16x32_bf16(Al, Bh, acc, 0, 0, 0);
            }
        }
#pragma unroll
        for (int i = 0; i < 4; ++i) PL[((rt * 2 + kh) * 16 + 4 * kg + i) * 16 + fr] = acc[i];
        __syncthreads();
        for (int v = tid; v < 64 * 16; v += NWAVES * 64) { const int rr = v >> 4, e = v & 15, t4 = rr >> 4, r16 = rr & 15;
            LOG[rr * 17 + e] = PL[((t4 * 2 + 0) * 16 + r16) * 16 + e] + PL[((t4 * 2 + 1) * 16 + r16) * 16 + e]; }
        __syncthreads();
        if (wave == 0) {
            const int row = rb0 + lane;
            float lg[16], mx = -INFINITY;
#pragma unroll
            for (int e = 0; e < 16; ++e) { lg[e] = LOG[lane * 17 + e]; mx = fmaxf(mx, lg[e]); }
            float sum = 0.f;
#pragma unroll
            for (int e = 0; e < 16; ++e) { lg[e] = __expf(lg[e] - mx); sum += lg[e]; }
            const float inv = 1.f / sum;
            float sel[16];
#pragma unroll
            for (int e = 0; e < 16; ++e) { lg[e] *= inv; sel[e] = lg[e] + rb[e]; }
            int grp = 0; float best = -INFINITY;
#pragma unroll
            for (int g = 0; g < 4; ++g) {
                float m1 = -INFINITY, m2 = -INFINITY;
#pragma unroll
                for (int i = 0; i < 4; ++i) { const float sv = sel[4 * g + i]; if (sv > m1) { m2 = m1; m1 = sv; } else if (sv > m2) m2 = sv; }
                const float gs = m1 + m2;
                if (gs > best) { best = gs; grp = g; }
            }
            float s4[4], p4[4];
#pragma unroll
            for (int i = 0; i < 4; ++i) { s4[i] = 0.f; p4[i] = 0.f; }
#pragma unroll
            for (int g = 0; g < 4; ++g)
#pragma unroll
                for (int i = 0; i < 4; ++i) if (g == grp) { s4[i] = sel[4 * g + i]; p4[i] = lg[4 * g + i]; }
            int i1 = 0; float b1 = s4[0];
#pragma unroll
            for (int i = 1; i < 4; ++i) if (s4[i] > b1) { b1 = s4[i]; i1 = i; }
            int i2 = -1; float b2 = -INFINITY;
#pragma unroll
            for (int i = 0; i < 4; ++i) if (i != i1 && s4[i] > b2) { b2 = s4[i]; i2 = i; }
            float pa = 0.f, pb = 0.f;
#pragma unroll
            for (int i = 0; i < 4; ++i) { if (i == i1) pa = p4[i]; if (i == i2) pb = p4[i]; }
            const int e1 = grp * 4 + i1, e2 = grp * 4 + i2;
            const float gi = 1.f / (pa + pb);
            const int p1 = __hip_atomic_fetch_add(lcnt + e1, 1, __ATOMIC_RELAXED, __HIP_MEMORY_SCOPE_WORKGROUP), p2 = __hip_atomic_fetch_add(lcnt + e2, 1, __ATOMIC_RELAXED, __HIP_MEMORY_SCOPE_WORKGROUP);
            llist[e1 * 128 + p1] = row * 2; llist[e2 * 128 + p2] = row * 2 + 1;
            lgate[e1 * 128 + p1] = pa * gi; lgate[e2 * 128 + p2] = pb * gi;
        }
        __syncthreads();
        if (tid < 16) lbase[tid] = atomicAdd(cnt + tid * CNT_STRIDE, lcnt[tid]);
        __syncthreads();
        for (int idx = tid; idx < 16 * 128; idx += NWAVES * 64) { const int e = idx >> 7, pos = idx & 127; if (pos < lcnt[e]) *(int2*)(list + 2 * (e * CAP + lbase[e] + pos)) = make_int2(llist[idx], __float_as_int(lgate[idx])); }
        __syncthreads();
    }
    __syncthreads();
}

typedef short bf16x8v __attribute__((ext_vector_type(8)));
typedef short s16x4 __attribute__((ext_vector_type(4)));
typedef float f32x16 __attribute__((ext_vector_type(16)));
#define MFMA32(a, b, c) __builtin_amdgcn_mfma_f32_32x32x16_bf16(a, b, c, 0, 0, 0)
__device__ __forceinline__ s16x4 lds_tr4(LAS const unsigned char* p) { return __builtin_bit_cast(s16x4, __builtin_amdgcn_ds_read_tr16_b64_v4i16((LAS s16x4*)p)); }
__device__ __forceinline__ bf16x8v cat8(s16x4 a, s16x4 b) { return (bf16x8v){a[0], a[1], a[2], a[3], b[0], b[1], b[2], b[3]}; }
__device__ __forceinline__ float max3f(float a, float b, float c) { float r; asm("v_max3_f32 %0, %1, %2, %3" : "=v"(r) : "v"(a), "v"(b), "v"(c)); return r; }
typedef float f32x2p __attribute__((ext_vector_type(2)));
__device__ __forceinline__ float xhalf_max(float v) { return fmaxf(v, __shfl_xor(v, 32)); }
__device__ __forceinline__ float xhalf_sum(float v) { return v + __shfl_xor(v, 32); }
__device__ __forceinline__ bf16x8v pack8(float a0, float a1, float a2, float a3, float a4, float a5, float a6, float a7) {
    pg8::u32x4 w; w.x = pg8::cvt_pk_bf16(a0, a1); w.y = pg8::cvt_pk_bf16(a2, a3); w.z = pg8::cvt_pk_bf16(a4, a5); w.w = pg8::cvt_pk_bf16(a6, a7);
    return __builtin_bit_cast(bf16x8v, w);
}

constexpr int DA_KPITCH = 144, DA_VPITCH = 320;
constexpr int DA_KBUF = 64 * DA_KPITCH, DA_VBUF = 64 * DA_VPITCH;
constexpr int DA_K_OFF = 0, DA_V_OFF = 4 * DA_KBUF, DA_END = DA_V_OFF + 2 * DA_VBUF;
constexpr int DA_XPITCH = 528;
static_assert(128 * DA_XPITCH <= DA_END, "exchange overlays the K/V buffers");

__device__ __forceinline__ void diff_attn_unit(LAS unsigned char* lds, const bf16_t* PROJ, bf16_t* MIX, int b, int h, int qblk, float lam, float lam_init, const float* subg, int tid, int lane, int wave) {
    const int m = wave >> 2, qs = wave & 3, ql = lane & 31, hi = lane >> 5;
    const int q0 = qblk * 128 + qs * 32, qpos = q0 + ql;
    const size_t rowb = (size_t)b * SEQ;
    const float slope2 = exp2f(-2.f * (float)(h + 1)) * 1.4426950408889634f;
    bf16x8v Qf[4];
#pragma unroll
    for (int s = 0; s < 4; ++s) Qf[s] = *(const bf16x8v*)(PROJ + (rowb + qpos) * EVEN_IN + 1024 + h * 128 + m * 64 + 16 * s + 8 * hi);
    float tab[16];
#pragma unroll
    for (int r = 0; r < 16; ++r) tab[r] = slope2 * (float)((r & 3) + 8 * (r >> 2));
    f32x16 O[4];
#pragma unroll
    for (int d = 0; d < 4; ++d)
#pragma unroll
        for (int r = 0; r < 16; ++r) O[d][r] = 0.f;
    float m_run = -INFINITY, l_run = 0.f;
    const int krow = tid >> 3, kch = tid & 7, vrow = tid >> 4, vch = tid & 15;
    const bf16_t* gk0 = PROJ + (rowb + krow) * EVEN_IN + 1536 + h * 128 + kch * 8;
    const bf16_t* gv0 = PROJ + (rowb + vrow) * EVEN_IN + 2048 + h * 128 + vch * 8;
    const int lk = krow * DA_KPITCH + kch * 16, lv = vrow * DA_VPITCH + vch * 16;
    const int ntiles = 2 * qblk + 2;
    pg8::u32x4 st[4];
#define DA_LOAD(kt) do { const size_t ro = (size_t)(kt) * 64 * EVEN_IN; st[0] = *(const pg8::u32x4*)(gk0 + ro); st[1] = *(const pg8::u32x4*)(gk0 + ro + 64); \
        st[2] = *(const pg8::u32x4*)(gv0 + ro); st[3] = *(const pg8::u32x4*)(gv0 + ro + (size_t)32 * EVEN_IN); } while (0)
#define DA_STORE(buf) do { *(LAS pg8::u32x4*)(lds + DA_K_OFF + ((buf) * 2 + 0) * DA_KBUF + lk) = st[0]; *(LAS pg8::u32x4*)(lds + DA_K_OFF + ((buf) * 2 + 1) * DA_KBUF + lk) = st[1]; \
        *(LAS pg8::u32x4*)(lds + DA_V_OFF + (buf) * DA_VBUF + lv) = st[2]; *(LAS pg8::u32x4*)(lds + DA_V_OFF + (buf) * DA_VBUF + lv + 32 * DA_VPITCH) = st[3]; } while (0)
    DA_LOAD(0); DA_STORE(0);
    __syncthreads();
    const int kbase = ql * DA_KPITCH + hi * 16;
    const int idx = lane & 15, tq = idx >> 2, tp = idx & 3, g16 = (lane >> 4) & 1;
    const int vbase = (4 * hi + tq) * DA_VPITCH + (16 * g16 + 4 * tp) * 2;
    for (int kt = 0; kt < ntiles; ++kt) {
        const int buf = kt & 1;
        if (kt + 1 < ntiles) DA_LOAD(kt + 1);
        if (64 * kt <= q0 + 31) {
            LAS const unsigned char* kp = lds + DA_K_OFF + (buf * 2 + m) * DA_KBUF + kbase;
            LAS const unsigned char* vp = lds + DA_V_OFF + buf * DA_VBUF + vbase;
            f32x16 S0, S1;
            const float base0 = slope2 * (float)(64 * kt + 4 * hi - qpos), base1 = base0 + slope2 * 32.f;
#pragma unroll
            for (int r = 0; r < 16; ++r) { S0[r] = base0 + tab[r]; S1[r] = base1 + tab[r]; }
#pragma unroll
            for (int s = 0; s < 4; ++s) {
                const bf16x8v a0 = *(LAS const bf16x8v*)(kp + 32 * s), a1 = *(LAS const bf16x8v*)(kp + 32 * s + 32 * DA_KPITCH);
                S0 = MFMA32(a0, Qf[s], S0); S1 = MFMA32(a1, Qf[s], S1);
            }
            if (64 * kt + 63 > q0) {
                const int kb = 64 * kt + 4 * hi;
#pragma unroll
                for (int r = 0; r < 16; ++r) { const int key = kb + (r & 3) + 8 * (r >> 2); if (key > qpos) S0[r] = -INFINITY; if (key + 32 > qpos) S1[r] = -INFINITY; }
            }
            float mxa = max3f(S0[0], S0[1], S1[0]), mxb = max3f(S0[2], S0[3], S1[1]);
            mxa = max3f(mxa, S1[2], S1[3]);
#pragma unroll
            for (int r = 4; r < 16; r += 4) { mxa = max3f(mxa, S0[r], S0[r + 1]); mxb = max3f(mxb, S0[r + 2], S0[r + 3]); mxa = max3f(mxa, S1[r], S1[r + 1]); mxb = max3f(mxb, S1[r + 2], S1[r + 3]); }
            const float mx = xhalf_max(fmaxf(mxa, mxb));
            const float m_new = fmaxf(m_run, mx), alpha = __builtin_amdgcn_exp2f(m_run - m_new);
            m_run = m_new;
            f32x2p ps2 = (f32x2p){0.f, 0.f};
#pragma unroll
            for (int r = 0; r < 16; r += 2) {
                S0[r] = __builtin_amdgcn_exp2f(S0[r] - m_new); S0[r + 1] = __builtin_amdgcn_exp2f(S0[r + 1] - m_new); S1[r] = __builtin_amdgcn_exp2f(S1[r] - m_new); S1[r + 1] = __builtin_amdgcn_exp2f(S1[r + 1] - m_new);
                ps2 += (f32x2p){S0[r], S0[r + 1]}; ps2 += (f32x2p){S1[r], S1[r + 1]};
            }
            const float ps = ps2.x + ps2.y;
            l_run = l_run * alpha + ps;
#pragma unroll
            for (int d = 0; d < 4; ++d)
#pragma unroll
                for (int r = 0; r < 16; ++r) O[d][r] *= alpha;
            bf16x8v Pb[4];
            Pb[0] = pack8(S0[0], S0[1], S0[2], S0[3], S0[4], S0[5], S0[6], S0[7]);
            Pb[1] = pack8(S0[8], S0[9], S0[10], S0[11], S0[12], S0[13], S0[14], S0[15]);
            Pb[2] = pack8(S1[0], S1[1], S1[2], S1[3], S1[4], S1[5], S1[6], S1[7]);
            Pb[3] = pack8(S1[8], S1[9], S1[10], S1[11], S1[12], S1[13], S1[14], S1[15]);
#pragma unroll
            for (int kk = 0; kk < 4; ++kk)
#pragma unroll
                for (int d = 0; d < 4; ++d) {
                    const s16x4 lo = lds_tr4(vp + (16 * kk) * DA_VPITCH + d * 64), hi4 = lds_tr4(vp + (16 * kk + 8) * DA_VPITCH + d * 64);
                    O[d] = MFMA32(cat8(lo, hi4), Pb[kk], O[d]);
                }
        }
        if (kt + 1 < ntiles) DA_STORE(buf ^ 1);
        __syncthreads();
    }
#undef DA_LOAD
#undef DA_STORE
    const float inv = 1.f / xhalf_sum(l_run);
    const float sc = (m == 1) ? inv * lam : inv;
    LAS float* xrow = (LAS float*)(lds + (qs * 32 + ql) * DA_XPITCH);
    if (m == 1) {
#pragma unroll
        for (int d = 0; d < 4; ++d)
#pragma unroll
            for (int g = 0; g < 4; ++g) *(LAS f32x4*)(xrow + 32 * d + 8 * g + 4 * hi) = (f32x4){O[d][4 * g] * sc, O[d][4 * g + 1] * sc, O[d][4 * g + 2] * sc, O[d][4 * g + 3] * sc};
    }
    __syncthreads();
    if (m == 0) {
        float ss = 0.f;
#pragma unroll
        for (int d = 0; d < 4; ++d)
#pragma unroll
            for (int g = 0; g < 4; ++g) { const f32x4 o2 = *(LAS const f32x4*)(xrow + 32 * d + 8 * g + 4 * hi);
#pragma unroll
                for (int i = 0; i < 4; ++i) { const float v = O[d][4 * g + i] * sc - o2[i]; O[d][4 * g + i] = v; ss += v * v; } }
        const float rn = rsqrtf(xhalf_sum(ss) * (1.f / 128.f) + 1e-6f) * (1.f - lam_init);
        bf16_t* orow = MIX + (rowb + qpos) * DM + 512 + h * 128;
#pragma unroll
        for (int d = 0; d < 4; ++d)
#pragma unroll
            for (int g = 0; g < 4; ++g) { const int dd = 32 * d + 8 * g + 4 * hi; const f32x4 sg = *(const f32x4*)(subg + dd);
                uint2 w; w.x = pg8::cvt_pk_bf16(O[d][4 * g] * rn * sg[0], O[d][4 * g + 1] * rn * sg[1]); w.y = pg8::cvt_pk_bf16(O[d][4 * g + 2] * rn * sg[2], O[d][4 * g + 3] * rn * sg[3]);
                *(uint2*)(orow + dd) = w; }
    }
    __syncthreads();
}

constexpr int SG_PITCH = 1024;
__device__ __forceinline__ int sg_addr(int row, int colbytes) { return row * SG_PITCH + ((((colbytes >> 6) ^ (row & 3)) << 6) | (colbytes & 63)); }
__device__ __forceinline__ void sgu_unit(LAS unsigned char* lds, const bf16_t* PROJ, bf16_t* MIX, const bf16_t* Wb, const float* bs, const float* lng, const float* lnb, int b, int c, int lane, int wave) {
    const size_t tok0 = (size_t)b * SEQ + c * 128;
    {
        float gw[8], gb[8];
#pragma unroll
        for (int i = 0; i < 8; ++i) { gw[i] = lng[lane * 8 + i]; gb[i] = lnb[lane * 8 + i]; }
        pg8::u32x4 raws[16];
#pragma unroll
        for (int i = 0; i < 16; ++i) raws[i] = *(const pg8::u32x4*)(PROJ + (tok0 + wave * 16 + i) * EVEN_IN + 512 + lane * 8);
#pragma unroll
        for (int i = 0; i < 16; ++i) {
            const int s = wave * 16 + i;
            const pg8::u32x4 raw = raws[i];
            float v[8];
            v[0] = __uint_as_float(raw.x << 16); v[1] = __uint_as_float(raw.x & 0xffff0000u); v[2] = __uint_as_float(raw.y << 16); v[3] = __uint_as_float(raw.y & 0xffff0000u);
            v[4] = __uint_as_float(raw.z << 16); v[5] = __uint_as_float(raw.z & 0xffff0000u); v[6] = __uint_as_float(raw.w << 16); v[7] = __uint_as_float(raw.w & 0xffff0000u);
            float sm = 0.f;
#pragma unroll
            for (int j = 0; j < 8; ++j) sm += v[j];
            const float mean = wave_sum(sm) * (1.f / 512.f);
            float sq = 0.f;
#pragma unroll
            for (int j = 0; j < 8; ++j) { v[j] -= mean; sq += v[j] * v[j]; }
            const float rstd = rsqrtf(wave_sum(sq) * (1.f / 512.f) + 1e-5f);
#pragma unroll
            for (int j = 0; j < 8; ++j) v[j] = v[j] * rstd * gw[j] + gb[j];
            *(LAS bf16x8v*)(lds + sg_addr(s, lane * 16)) = pack8(v[0], v[1], v[2], v[3], v[4], v[5], v[6], v[7]);
        }
    }
    __syncthreads();
    const int g = wave >> 1, th = wave & 1, tl = lane & 31, hi = lane >> 5;
    const int idx = lane & 15, tq = idx >> 2, tp = idx & 3, g16 = (lane >> 4) & 1;
    for (int t2 = 0; t2 < 2; ++t2) {
        const int tt = 2 * th + t2;
        f32x16 acc[4];
#pragma unroll
        for (int d = 0; d < 4; ++d)
#pragma unroll
            for (int r = 0; r < 16; ++r) acc[d][r] = 0.f;
        const bf16_t* wrow = Wb + ((size_t)g * 128 + 32 * tt + tl) * 128 + 8 * hi;
        const int nks = 2 * (tt + 1);
        for (int ks = 0; ks < nks; ++ks) {
            const bf16x8v bw = *(const bf16x8v*)(wrow + 16 * ks);
            const int r0 = 16 * ks + 8 * hi + tq;
#pragma unroll
            for (int d = 0; d < 4; ++d) {
                const int cb = (g * 128 + 32 * d + 16 * g16 + 4 * tp) * 2;
                const s16x4 lo = lds_tr4(lds + sg_addr(r0, cb)), hi4 = lds_tr4(lds + sg_addr(r0 + 4, cb));
                acc[d] = MFMA32(cat8(lo, hi4), bw, acc[d]);
            }
        }
        const int t = 32 * tt + tl; const size_t tok = tok0 + t;
        const float bias = bs[g * 128 + t];
#pragma unroll
        for (int d = 0; d < 4; ++d)
#pragma unroll
            for (int gg = 0; gg < 4; ++gg) { const int ch = g * 128 + 32 * d + 8 * gg + 4 * hi;
                const uint2 ur = *(const uint2*)(PROJ + tok * EVEN_IN + ch);
                const float u0 = __uint_as_float(ur.x << 16), u1 = __uint_as_float(ur.x & 0xffff0000u), u2 = __uint_as_float(ur.y << 16), u3 = __uint_as_float(ur.y & 0xffff0000u);
                uint2 w; w.x = pg8::cvt_pk_bf16(u0 * (acc[d][4 * gg] + bias), u1 * (acc[d][4 * gg + 1] + bias)); w.y = pg8::cvt_pk_bf16(u2 * (acc[d][4 * gg + 2] + bias), u3 * (acc[d][4 * gg + 3] + bias));
                *(uint2*)(MIX + tok * DM + ch) = w; }
    }
    __syncthreads();
}

__device__ __forceinline__ void phase_even_mixer(const Args& a, LAS unsigned char* lds, int l, int tid, int lane, int wave) {
    asm volatile("" : "+v"(tid), "+v"(lane));
    unsigned char* wsp = a.ws;
    const int i = l >> 1, c = blockIdx.x;
    const bf16_t* PROJ = (const bf16_t*)(wsp + WS_PROJ); bf16_t* MIX = (bf16_t*)(wsp + WS_MIX);
    const float lam_init = (l == 0) ? 0.2f : 0.47071301834305654f;
    const float lam = __expf(wave_sum(a.in[12][i * 64 + lane] * a.in[13][i * 64 + lane])) - __expf(wave_sum(a.in[14][i * 64 + lane] * a.in[15][i * 64 + lane])) + lam_init;
    for (int cc = c; cc < 256; cc += gridDim.x) {
        const int bh = cc & 31, j = cc >> 5, b = bh >> 2, h = bh & 3;
        for (int u = 0; u < 2; ++u) diff_attn_unit(lds, PROJ, MIX, b, h, u ? j : 15 - j, lam, lam_init, a.in[16] + i * 128, tid, lane, wave);
    }
    for (int cc = c; cc < 128; cc += gridDim.x)
        sgu_unit(lds, PROJ, MIX, (const bf16_t*)(wsp + WS_SGUW) + (size_t)i * 4 * 128 * 128, a.in[11] + i * 512, a.in[8] + i * 512, a.in[9] + i * 512, cc >> 4, cc & 15, lane, wave);
}
constexpr int DL_VPITCH = 192, DL_VBUF = 32 * DL_VPITCH;
__device__ __forceinline__ void dil_attn_unit(LAS unsigned char* lds, const bf16_t* PROJ, bf16_t* OG, float* LSE, bf16_t* MIX, int b, int h, int blk, int tid, int lane, int wave) {
    const int ql = lane & 31, hi = lane >> 5;
    const int idx = lane & 15, tq = idx >> 2, tp = idx & 3, g16 = (lane >> 4) & 1;
    const size_t rowb = (size_t)b * SEQ;
    const int blk0 = blk * 512;
    const float slope2 = exp2f(-(float)(h + 1)) * 1.4426950408889634f;
    LAS unsigned char* vl = lds + wave * (2 * DL_VBUF);
    const int vrow = lane >> 3, vch = lane & 7;
    const int vbase = (4 * hi + tq) * DL_VPITCH + (16 * g16 + 4 * tp) * 2;
    for (int it = wave; it < 32; it += NWAVES) {
        const int g = it < 16 ? (it >> 3) : 2, j = it < 16 ? (it & 7) : (it - 16);
        const int nh = (g == 2) ? 1 : 2;
        const int dil = (g == 0) ? 1 : (g == 1 ? 4 : 16);
        const int pbase = blk0 + ((g == 0) ? 64 * j : (g == 1 ? (j & 3) + 256 * (j >> 2) : j));
        bf16x8v Qf[2][4];
#pragma unroll
        for (int hh = 0; hh < 2; ++hh) { const int qp = pbase + dil * (32 * (hh < nh ? hh : 0) + ql); const bf16_t* qrow = PROJ + (rowb + qp) * ODD_IN + g * 512 + h * 64 + 8 * hi;
#pragma unroll
            for (int s = 0; s < 4; ++s) Qf[hh][s] = *(const bf16x8v*)(qrow + 16 * s); }
        f32x16 O[2][2];
#pragma unroll
        for (int hh = 0; hh < 2; ++hh)
#pragma unroll
            for (int d = 0; d < 2; ++d)
#pragma unroll
                for (int r = 0; r < 16; ++r) O[hh][d][r] = 0.f;
        float m_run[2] = {-INFINITY, -INFINITY}, l_run[2] = {0.f, 0.f};
        int c0 = -4;
        while (pbase + dil * 32 * c0 < 0) ++c0;
        const int clast = nh - 1;
        const bf16_t* kcol = PROJ + 1536 + g * 512 + h * 64 + 8 * hi;
        const bf16_t* vcol = PROJ + 3072 + h * 64 + vch * 8;
        bf16x8v kc[4], kn[4]; pg8::u32x4 vn[4];
#define DL_LOADK(dst, c) do { const bf16_t* kr = kcol + (rowb + pbase + dil * (32 * (c) + ql)) * ODD_IN; _Pragma("unroll") for (int s = 0; s < 4; ++s) dst[s] = *(const bf16x8v*)(kr + 16 * s); } while (0)
#define DL_LOADV(c) do { _Pragma("unroll") for (int n = 0; n < 4; ++n) vn[n] = *(const pg8::u32x4*)(vcol + (rowb + pbase + dil * (32 * (c) + vrow + 8 * n)) * ODD_IN); } while (0)
#define DL_STOREV(buf) do { _Pragma("unroll") for (int n = 0; n < 4; ++n) *(LAS pg8::u32x4*)(vl + (buf) * DL_VBUF + (vrow + 8 * n) * DL_VPITCH + vch * 16) = vn[n]; } while (0)
        DL_LOADK(kc, c0); DL_LOADV(c0); DL_STOREV(c0 & 1);
        for (int c = c0; c <= clast; ++c) {
            if (c < clast) { DL_LOADK(kn, c + 1); DL_LOADV(c + 1); }
            LAS const unsigned char* vp = vl + (c & 1) * DL_VBUF + vbase;
#pragma unroll
            for (int hh = 0; hh < 2; ++hh) {
                const int ch = c - hh;
                if (hh < nh && ch >= -4 && ch <= 0) {
                    f32x16 S;
                    const float base = slope2 * (float)(32 * ch + 4 * hi - ql);
#pragma unroll
                    for (int r = 0; r < 16; ++r) S[r] = fmaf(slope2, (float)((r & 3) + 8 * (r >> 2)), base);
#pragma unroll
                    for (int s = 0; s < 4; ++s) S = MFMA32(kc[s], Qf[hh][s], S);
                    if (ch == -4) {
#pragma unroll
                        for (int r = 0; r < 16; ++r) { const int kk = 4 * hi + (r & 3) + 8 * (r >> 2); if (kk < ql) S[r] = -INFINITY; }
                    }
                    if (ch == 0) {
#pragma unroll
                        for (int r = 0; r < 16; ++r) { const int kk = 4 * hi + (r & 3) + 8 * (r >> 2); if (kk > ql) S[r] = -INFINITY; }
                    }
                    float mx = S[0];
#pragma unroll
                    for (int r = 1; r < 16; ++r) mx = fmaxf(mx, S[r]);
                    mx = xhalf_max(mx);
                    const float m_new = fmaxf(m_run[hh], mx), alpha = __builtin_amdgcn_exp2f(m_run[hh] - m_new);
                    m_run[hh] = m_new;
                    float ps = 0.f;
#pragma unroll
                    for (int r = 0; r < 16; ++r) { S[r] = __builtin_amdgcn_exp2f(S[r] - m_new); ps += S[r]; }
                    l_run[hh] = l_run[hh] * alpha + ps;
#pragma unroll
                    for (int d = 0; d < 2; ++d)
#pragma unroll
                        for (int r = 0; r < 16; ++r) O[hh][d][r] *= alpha;
                    bf16x8v Pb[2];
                    Pb[0] = pack8(S[0], S[1], S[2], S[3], S[4], S[5], S[6], S[7]);
                    Pb[1] = pack8(S[8], S[9], S[10], S[11], S[12], S[13], S[14], S[15]);
#pragma unroll
                    for (int ks = 0; ks < 2; ++ks)
#pragma unroll
                        for (int d = 0; d < 2; ++d) {
                            const s16x4 lo = lds_tr4(vp + (16 * ks) * DL_VPITCH + d * 64), hi4 = lds_tr4(vp + (16 * ks + 8) * DL_VPITCH + d * 64);
                            O[hh][d] = MFMA32(cat8(lo, hi4), Pb[ks], O[hh][d]);
                        }
                }
            }
            if (c < clast) {
                DL_STOREV((c + 1) & 1);
#pragma unroll
                for (int s = 0; s < 4; ++s) kc[s] = kn[s];
            }
        }
#undef DL_LOADK
#undef DL_LOADV
#undef DL_STOREV
#pragma unroll
        for (int hh = 0; hh < 2; ++hh) {
            if (hh < nh) {
                const int qp = pbase + dil * (32 * hh + ql);
                const float lt = xhalf_sum(l_run[hh]), inv = 1.f / lt;
                bf16_t* orow = OG + ((size_t)g * T + rowb + qp) * 512 + h * 64;
#pragma unroll
                for (int d = 0; d < 2; ++d)
#pragma unroll
                    for (int gg = 0; gg < 4; ++gg) { uint2 w; w.x = pg8::cvt_pk_bf16(O[hh][d][4 * gg] * inv, O[hh][d][4 * gg + 1] * inv); w.y = pg8::cvt_pk_bf16(O[hh][d][4 * gg + 2] * inv, O[hh][d][4 * gg + 3] * inv);
                        *(uint2*)(orow + 32 * d + 8 * gg + 4 * hi) = w; }
                if (hi == 0) LSE[((size_t)g * T + rowb + qp) * 8 + h] = m_run[hh] + __log2f(lt);
            }
        }
    }
    VM_WAIT();
    __syncthreads();
#pragma unroll
    for (int k8 = 0; k8 < 8; ++k8) { const int id = tid + k8 * (NWAVES * 64);
        const int p = id >> 3, ch = id & 7; const size_t tok = rowb + blk0 + p;
        float ls[3], mxl = -INFINITY;
#pragma unroll
        for (int g = 0; g < 3; ++g) { ls[g] = LSE[((size_t)g * T + tok) * 8 + h]; mxl = fmaxf(mxl, ls[g]); }
        float wsum = 0.f;
#pragma unroll
        for (int g = 0; g < 3; ++g) { ls[g] = __builtin_amdgcn_exp2f(ls[g] - mxl); wsum += ls[g]; }
        const float wi = 1.f / wsum;
        float o[8];
#pragma unroll
        for (int i = 0; i < 8; ++i) o[i] = 0.f;
#pragma unroll
        for (int g = 0; g < 3; ++g) {
            const pg8::u32x4 raw = *(const pg8::u32x4*)(OG + ((size_t)g * T + tok) * 512 + h * 64 + ch * 8);
            const float wg = ls[g] * wi;
            o[0] += wg * __uint_as_float(raw.x << 16); o[1] += wg * __uint_as_float(raw.x & 0xffff0000u); o[2] += wg * __uint_as_float(raw.y << 16); o[3] += wg * __uint_as_float(raw.y & 0xffff0000u);
            o[4] += wg * __uint_as_float(raw.z << 16); o[5] += wg * __uint_as_float(raw.z & 0xffff0000u); o[6] += wg * __uint_as_float(raw.w << 16); o[7] += wg * __uint_as_float(raw.w & 0xffff0000u);
        }
        *(bf16x8v*)(MIX + tok * DM + h * 64 + ch * 8) = pack8(o[0], o[1], o[2], o[3], o[4], o[5], o[6], o[7]);
    }
    __syncthreads();
}

constexpr int CV_ROWS = 94, CV_PITCH = 1024, CV_RED_OFF = 98304;
__device__ __forceinline__ void conv_unit(LAS unsigned char* lds, const bf16_t* PROJ, bf16_t* MIX, const float* cw, const float* cb, const float* lg, const float* lb, int tile, int tid, int lane, int wave) {
    asm volatile("" : "+v"(tid), "+v"(lane));
    const int t0 = tile * 64, s0 = t0 % SEQ;
    {
#pragma unroll
        for (int k = 0; k < 12; ++k) {
            const int id = tid + k * (NWAVES * 64), r = id >> 6, ch = id & 63;
            if (r < CV_ROWS) {
                pg8::u32x4 w = (pg8::u32x4){0u, 0u, 0u, 0u};
                if (s0 - 30 + r >= 0) {
                    const bf16_t* p = PROJ + (size_t)(t0 - 30 + r) * ODD_IN + 3584 + 8 * ch;
                    const pg8::u32x4 av = *(const pg8::u32x4*)p, gv = *(const pg8::u32x4*)(p + 512);
#pragma unroll
                    for (int q = 0; q < 4; ++q) { const float a0 = __uint_as_float(av[q] << 16), a1 = __uint_as_float(av[q] & 0xffff0000u), g0 = __uint_as_float(gv[q] << 16), g1 = __uint_as_float(gv[q] & 0xffff0000u);
                        w[q] = pg8::cvt_pk_bf16(a0 * fast_sigmoid(g0), a1 * fast_sigmoid(g1)); }
                }
                *(LAS pg8::u32x4*)(lds + r * CV_PITCH + ch * 16) = w;
            }
        }
    }
    const int c = tid;
    float w[31];
#pragma unroll
    for (int k = 0; k < 31; ++k) w[k] = cw[k * 512 + c];
    const float bias = cb[c];
    __syncthreads();
    float o[64];
#pragma unroll
    for (int tg = 0; tg < 16; ++tg) {
        float x[34];
#pragma unroll
        for (int r = 0; r < 34; ++r) x[r] = __uint_as_float((unsigned)(*(LAS const unsigned short*)(lds + (4 * tg + r) * CV_PITCH + c * 2)) << 16);
#pragma unroll
        for (int jj = 0; jj < 4; ++jj) {
            float a = bias;
#pragma unroll
            for (int k = 0; k < 31; ++k) a += w[k] * x[jj + k];
            o[4 * tg + jj] = a;
        }
    }
    int rbo = CV_RED_OFF; asm volatile("" : "+v"(rbo));
    LAS float* red = (LAS float*)(lds + rbo);
#pragma unroll
    for (int rd = 0; rd < 2; ++rd) {
        float v[64];
#pragma unroll
        for (int t = 0; t < 32; ++t) { v[2 * t] = o[32 * rd + t]; v[2 * t + 1] = o[32 * rd + t] * o[32 * rd + t]; }
#pragma unroll
        for (int n = 32; n >= 1; n >>= 1) {
            const bool up = (lane & n) != 0;
#pragma unroll
            for (int k = 0; k < n; ++k) { const float keep = up ? v[k + n] : v[k], send = up ? v[k] : v[k + n]; v[k] = keep + __shfl_xor(send, n); }
        }
        red[(wave * 2 + rd) * 64 + lane] = v[0];
    }
    __syncthreads();
    if (tid < 64) {
        float sm = 0.f, sq = 0.f;
#pragma unroll
        for (int wv = 0; wv < 8; ++wv) { sm += red[(wv * 2 + (tid >> 5)) * 64 + 2 * (tid & 31)]; sq += red[(wv * 2 + (tid >> 5)) * 64 + 2 * (tid & 31) + 1]; }
        const float mean = sm * (1.f / 512.f), var = sq * (1.f / 512.f) - mean * mean;
        red[1024 + 2 * tid] = mean; red[1024 + 2 * tid + 1] = rsqrtf(fmaxf(var, 0.f) + 1e-5f);
    }
    __syncthreads();
    const float gq = lg[c], bq = lb[c];
#pragma unroll
    for (int t = 0; t < 64; ++t) {
        const float mean = red[1024 + 2 * t], rstd = red[1024 + 2 * t + 1];
        const float y = (o[t] - mean) * rstd * gq + bq;
        *(LAS unsigned short*)(lds + t * CV_PITCH + c * 2) = f2bf(y * fast_sigmoid(y));
    }
    __syncthreads();
#pragma unroll
    for (int k8 = 0; k8 < 8; ++k8) { const int id = tid + k8 * (NWAVES * 64); const int t = id >> 6, ch = id & 63;
        *(pg8::u32x4*)(MIX + (size_t)(t0 + t) * DM + 512 + ch * 8) = *(LAS const pg8::u32x4*)(lds + t * CV_PITCH + ch * 16); }
    __syncthreads();
}

#ifndef RP_DIL
#define RP_DIL 1
#endif
#ifndef RP_CONV
#define RP_CONV 1
#endif
#ifndef REPEAT
#define REPEAT(n) _Pragma("unroll 1") for (int rep_ = 0; rep_ < (n); ++rep_)
#endif
__device__ __forceinline__ void phase_odd_mixer(const Args& a, LAS unsigned char* lds, int l, int tid, int lane, int wave) {
    asm volatile("" : "+v"(tid), "+v"(lane));
    unsigned char* wsp = a.ws;
    const int i = l >> 1;
    const bf16_t* PROJ = (const bf16_t*)(wsp + WS_PROJ); bf16_t* MIX = (bf16_t*)(wsp + WS_MIX);
    REPEAT(RP_DIL) for (int cc = blockIdx.x; cc < 256; cc += gridDim.x) {
        const int bh = cc & 63, blk = cc >> 6;
        dil_attn_unit(lds, PROJ, (bf16_t*)(wsp + WS_OG), (float*)(wsp + WS_LSE), MIX, bh >> 3, bh & 7, blk, tid, lane, wave);
    }
    REPEAT(RP_CONV) for (int cc = blockIdx.x; cc < 256; cc += gridDim.x)
        conv_unit(lds, PROJ, MIX, a.in[19] + (size_t)i * 31 * 512, a.in[20] + i * 512, a.in[21] + i * 512, a.in[22] + i * 512, cc, tid, lane, wave);
}
#ifndef RP_PRO
#define RP_PRO 1
#endif
#ifndef RP_NORM0
#define RP_NORM0 1
#endif
#ifndef RP_INPROJ
#define RP_INPROJ 1
#endif
#ifndef RP_MIXE
#define RP_MIXE 1
#endif
#ifndef RP_MIXO
#define RP_MIXO 1
#endif
#ifndef RP_OUT0
#define RP_OUT0 1
#endif
#ifndef RP_ROUTER
#define RP_ROUTER 1
#endif
#ifndef RP_GU
#define RP_GU 1
#endif
#ifndef RP_DOWN
#define RP_DOWN 1
#endif
#ifndef RP_COMB
#define RP_COMB 1
#endif
#ifndef RP_BAR
#define RP_BAR 1
#endif
#ifndef REPEAT
#define REPEAT(n) _Pragma("unroll 1") for (int rep_ = 0; rep_ < (n); ++rep_)
#endif
constexpr int N_PHASES = 2 + 7 * DEPTH;

__global__ void __launch_bounds__(NWAVES * 64, 2) mega(Args a) {
    extern __shared__ __attribute__((aligned(16))) unsigned char lds_raw[];
    LAS unsigned char* lds = (LAS unsigned char*)lds_raw;
    volatile LAS unsigned* MISC = (volatile LAS unsigned*)(lds + MISC_OFF);
    const int wave = __builtin_amdgcn_readfirstlane((int)threadIdx.x >> 6), G = gridDim.x;
#define tid (wave * 64 + hw_lane())
#define lane hw_lane()
    const int gw = blockIdx.x * NWAVES + wave, NGW = G * NWAVES;
    unsigned char* ws = a.ws;
    gu32* ctl = (gu32*)(ws + WS_CTL);
    for (int u = tid; u < (LDS_BYTES - LDSCTL_OFF) / 4; u += NWAVES * 64) ((LAS unsigned*)(lds + LDSCTL_OFF))[u] = 0u;
    __syncthreads();
    XcdBarrier bar = xcd_barrier_post((unsigned*)ctl + CW_BAR + a.li * 4096, MISC + 8, wave);
#define IN(k) true
#define SEAM(k) do { if ((k) + 1 < N_PHASES) { REPEAT(RP_BAR) xcd_barrier(bar, wave); } } while (0)

    if (IN(0) || IN(1)) {
    float* MOD = (float*)(ws + WS_MOD); bf16_t* XN = (bf16_t*)(ws + WS_XN);
    if (IN(0)) { REPEAT(RP_PRO) p0_prologue(a, lds, tid, lane, wave, G); SEAM(0); }
    if (IN(1)) { REPEAT(RP_NORM0) phase_norm1<0>(a.in[0], nullptr, nullptr, nullptr, nullptr, a.in[2], MOD + 1 * DM, MOD + 0 * DM, XN, nullptr, lane, gw, NGW); SEAM(1); }
    }
    for (int l = 0; l < DEPTH; ++l) {
        const int pb = 2 + 7 * l, i = l >> 1;
        ctl = (gu32*)(ws + WS_CTL);
        float* MOD = (float*)(ws + WS_MOD); bf16_t* X = (bf16_t*)(ws + WS_X); bf16_t* XB = (bf16_t*)(ws + WS_XB);
        bf16_t* XN = (bf16_t*)(ws + WS_XN); bf16_t* PROJ = (bf16_t*)(ws + WS_PROJ); bf16_t* MIX = (bf16_t*)(ws + WS_MIX);
        bf16_t* ACT = (bf16_t*)(ws + WS_ACT); bf16_t* YS = (bf16_t*)(ws + WS_YS); int* LIST = (int*)(ws + WS_LIST); float* GATE = (float*)(ws + WS_GATE);
        const float* mod = MOD + (size_t)l * NB * 6144;
        int* cnt = (int*)ctl + CW_CNT + l * 16 * CNT_STRIDE;
        if (IN(pb + 0)) {
            const bool ev = (l & 1) == 0;
            pg8::Gemm g{XN, ev ? (const bf16_t*)(ws + WS_WT_EV_IN) + (size_t)i * EVEN_IN * DM : (const bf16_t*)(ws + WS_WT_OD_IN) + (size_t)i * ODD_IN * DM, DM, 0};
            pg8::StaticOrder S; S.init(T, ev ? EVEN_IN : ODD_IN, G, (int)blockIdx.x);
            EpiProj E{PROJ, ev ? EVEN_IN : ODD_IN, (FUSE_PROJ_ACT && ev) ? 4 : 0, FUSE_PROJ_ACT ? (ev ? 4 : 0) : 0, FUSE_PROJ_ACT ? 6 : 0};
            REPEAT(RP_INPROJ) pg8::gemm_phase<EpiProj, pg8::StaticOrder>(lds + RING_OFF, g, S, E, wave);
            { int fr_, fn_; const bool fp_ = S.filler_rank(fr_, fn_); const int b1 = conv_b1(l); filler_convert(a, lds, l, b1 + CONV_GU_SPLIT, b1 + 8192, fp_, fr_, fn_, wave); }
            SEAM(pb + 0);
        }
        if (IN(pb + 1)) {
            if ((l & 1) == 0) { REPEAT(RP_MIXE) phase_even_mixer(a, lds, l, tid, lane, wave); }
            else { REPEAT(RP_MIXO) phase_odd_mixer(a, lds, l, tid, lane, wave); }
            SEAM(pb + 1);
        }
        if (IN(pb + 2)) {
            const bool ev = (l & 1) == 0;
            pg8::Gemm g{MIX, (const bf16_t*)(ws + (ev ? WS_WT_EV_OUT : WS_WT_OD_OUT)) + (size_t)i * DM * DM, DM, 0};
            pg8::StaticOrder S; S.init(T, DM, G, (int)blockIdx.x);
            EpiOut E{l == 0 ? a.in[0] : nullptr, XB, X, mod + 2 * DM};
            REPEAT(RP_OUT0) pg8::gemm_phase<EpiOut, pg8::StaticOrder>(lds + RING_OFF, g, S, E, wave);
            SEAM(pb + 2);
        }
        if (IN(pb + 3)) {
            phase_router(lds, X, a.in[3] + l * DM, mod + 4 * DM, mod + 3 * DM, (const bf16_t*)(ws + WS_WRT), a.in[24], XN, cnt, LIST, GATE, wave);
            REPEAT(RP_ROUTER - 1) phase_router(lds, X, a.in[3] + l * DM, mod + 4 * DM, mod + 3 * DM, (const bf16_t*)(ws + WS_WRT), a.in[24], XN, (int*)ctl + 8192 + l * 16 * CNT_STRIDE, (int*)(ws + WS_OG), (float*)(ws + WS_OG + 2 * MiB), wave);
            SEAM(pb + 3);
        }
        if (IN(pb + 4)) {
            pg8::Gemm g{XN, (const bf16_t*)(ws + WS_WT_GU) + (size_t)l * NEXP * 1024 * DM, DM, (size_t)1024 * DM};
            LAS int* ctab = (LAS int*)(lds + LDSCTL_OFF + 1024);
            { const int t_ = tid; if (t_ < NEXP) ctab[t_] = __hip_atomic_load(cnt + t_ * CNT_STRIDE, RLX_AGENT); } __syncthreads();
            pg8::MoeOrder<1> S{ctab, LIST, 4, G, (int)blockIdx.x};
            EpiGU E{ACT, LIST, GATE};
            REPEAT(RP_GU) pg8::gemm_phase<EpiGU, pg8::MoeOrder<1>>(lds + RING_OFF, g, S, E, wave, (LAS unsigned long long*)(lds + LDSCTL_OFF + 2048));
            { int fr_, fn_; const bool fp_ = S.filler_rank(fr_, fn_); const int b2 = conv_b1(l) + 8192; filler_convert(a, lds, l, b2, b2 + 4096, fp_, fr_, fn_, wave);
              if (l + 1 < DEPTH) filler_convert(a, lds, l + 1, 0, conv_b1(l + 1), fp_, fr_, fn_, wave); }
            SEAM(pb + 4);
        }
        if (IN(pb + 5)) {
            pg8::Gemm g{ACT, (const bf16_t*)(ws + WS_WT_DN) + (size_t)l * NEXP * DM * EFF, EFF, (size_t)DM * EFF};
            LAS int* ctab = (LAS int*)(lds + LDSCTL_OFF + 1024);
            { const int t_ = tid; if (t_ < NEXP) ctab[t_] = __hip_atomic_load(cnt + t_ * CNT_STRIDE, RLX_AGENT); } __syncthreads();
            pg8::MoeOrder<0> S{ctab, LIST, 4, G, (int)blockIdx.x};
            EpiDown E{YS, LIST};
            REPEAT(RP_DOWN) pg8::gemm_phase<EpiDown, pg8::MoeOrder<0>>(lds + RING_OFF, g, S, E, wave, (LAS unsigned long long*)(lds + LDSCTL_OFF + 2048));
            if (l + 1 < DEPTH) { int fr_, fn_; const bool fp_ = S.filler_rank(fr_, fn_); const int b1 = conv_b1(l + 1); filler_convert(a, lds, l + 1, b1, b1 + CONV_GU_SPLIT, fp_, fr_, fn_, wave); }
            SEAM(pb + 5);
        }
        if (IN(pb + 6)) {
            if (l + 1 < DEPTH) REPEAT(RP_COMB) phase_norm1<1>(nullptr, X, XB, YS, mod + 5 * DM, a.in[2] + (l + 1) * DM, mod + NB * 6144 + 1 * DM, mod + NB * 6144 + 0 * DM, XN, nullptr, lane, gw, NGW);
            else REPEAT(RP_COMB) phase_norm1<2>(nullptr, X, nullptr, YS, mod + 5 * DM, a.in[27], nullptr, nullptr, nullptr, a.out, lane, gw, NGW);
            SEAM(pb + 6);
        }
    }
#undef IN
#undef SEAM
#undef tid
#undef lane
}
static void launch_mega(const Args& base, int lo, int hi, int li, int grid, hipStream_t stream) {
    Args a = base; a.ph_lo = lo; a.ph_hi = hi; a.li = li; a.pad = 0;
    hipLaunchKernelGGL(mega, dim3(grid), dim3(NWAVES * 64), LDS_BYTES, stream, a);
}
extern "C" void kernel_launch(void* const* d_in, const int* in_sizes, int n_in, void* d_out, int out_size, void* d_ws, size_t ws_size, hipStream_t stream) {
    static int grid = 0;
    if (grid == 0) {
        if (ws_size < WS_END2 || n_in != 28) { fprintf(stderr, "kernel_launch: workspace too small or wrong inputs: %zu < %zu, n_in %d\n", ws_size, (size_t)WS_END2, n_in); grid = -1; return; }
        int dev = 0, cus = 0;
        if (hipGetDevice(&dev) != hipSuccess || hipDeviceGetAttribute(&cus, hipDeviceAttributeMultiprocessorCount, dev) != hipSuccess) { grid = -1; return; }
        if (hipFuncSetAttribute((const void*)mega, hipFuncAttributeMaxDynamicSharedMemorySize, LDS_BYTES) != hipSuccess) { fprintf(stderr, "kernel_launch: hipFuncSetAttribute failed\n"); grid = -1; return; }
        int per_cu = 0;
        if (hipOccupancyMaxActiveBlocksPerMultiprocessor(&per_cu, (const void*)mega, NWAVES * 64, LDS_BYTES) != hipSuccess || per_cu < 1) fprintf(stderr, "kernel_launch: occupancy query reports %d\n", per_cu);
        (void)hipGetLastError();
        grid = cus;
    }
    if (grid < 0) return;
    const float* sgu_ln_g = (const float*)d_in[8]; const float* sgu_ln_b = (const float*)d_in[9];
    const float* sgu_w = (const float*)d_in[10]; const float* sgu_b = (const float*)d_in[11];
    const float* lam_q1 = (const float*)d_in[12]; const float* lam_k1 = (const float*)d_in[13];
    const float* lam_q2 = (const float*)d_in[14]; const float* lam_k2 = (const float*)d_in[15];
    const float* subln_g = (const float*)d_in[16];
    const float* conv_w = (const float*)d_in[19]; const float* conv_b = (const float*)d_in[20];
    const float* conv_ln_g = (const float*)d_in[21]; const float* conv_ln_b = (const float*)d_in[22];
    unsigned char* ws = (unsigned char*)d_ws;
    bf16_t* PROJ = (bf16_t*)(ws + WS_PROJ); bf16_t* MIX = (bf16_t*)(ws + WS_MIX); bf16_t* VN = (bf16_t*)(ws + WS_VN);

    (void)hipMemsetAsync(ws + WS_CTL, 0, 1 * MiB, stream);
    Args a{};
    for (int i = 0; i < 28; ++i) a.in[i] = (const float*)d_in[i];
    a.out = (float*)d_out; a.ws = ws;
    int li = 0;
    launch_mega(a, 0, N_PHASES, li++, grid, stream);
}
```
